# Optimizing an MI355X kernel written in HIP

```python
import math
import jax, jax.numpy as jnp
from jax import lax
import numpy as np

D_MODEL = 2048
BATCH = 4
SEQ = 2048
DEPTH = 1
DEC_BATCH = 128
DEC_SEQ = 4
PAST_LEN = 2048
PAGE_SIZE = 128

MIX_WIDTH = D_MODEL
NSA_WIDTH = MIX_WIDTH // 2
CONV_DIM = MIX_WIDTH - NSA_WIDTH
HEAD_DIM = 128
N_HEADS = NSA_WIDTH // HEAD_DIM
N_KV_HEADS = 2
CMP_BLOCK = 32
CMP_STRIDE = 16
SEL_BLOCK = 64
N_SELECT = 16
WINDOW = 512
CONV_WIDTH = 31
N_CACHE_SLOTS = 4
N_WIN_SLOTS = 2
N_BRANCH = 3
Q_COLS = N_HEADS * HEAD_DIM
KV_COLS = N_CACHE_SLOTS * N_KV_HEADS * HEAD_DIM
WIN_COLS = N_WIN_SLOTS * N_KV_HEADS * HEAD_DIM
GATE_COLS = N_BRANCH * N_HEADS
IN_COLS = Q_COLS + KV_COLS + WIN_COLS + GATE_COLS + NSA_WIDTH + 2 * CONV_DIM + CONV_DIM
SEL_QROWS = 128
WIN_QBLK = 128
NORM_EPS = 1e-6
NEG_INF = -1e30
FORCE_BONUS = 1e6

kernel_name = 'nsa_conformer_hybrid_step'


def _rmsnorm(x, g):
    x32 = x.astype(jnp.float32)
    y = x32 * lax.rsqrt(jnp.mean(x32 * x32, -1, keepdims=True) + NORM_EPS)
    return (y * g.astype(jnp.float32)).astype(x.dtype)


def _layernorm(x, g, b):
    x32 = x.astype(jnp.float32)
    mu = jnp.mean(x32, -1, keepdims=True)
    var = jnp.mean(jnp.square(x32 - mu), -1, keepdims=True)
    return ((x32 - mu) * lax.rsqrt(var + NORM_EPS) * g.astype(jnp.float32) + b.astype(jnp.float32)).astype(x.dtype)


def _masked_softmax(s, mask):
    s = jnp.where(mask, s, NEG_INF)
    e = jnp.where(mask, jnp.exp(s - jnp.max(s, -1, keepdims=True)), 0.0)
    return e / jnp.maximum(jnp.sum(e, -1, keepdims=True), 1e-30)


def _block_size(n, target):
    b = max(1, min(n, target))
    while n % b:
        b -= 1
    return b


def _compress(kv_cmp, pe, w1, b1, w2, b2):
    L = kv_cmp.shape[1]
    n_cmp = (L - CMP_BLOCK) // CMP_STRIDE + 1
    idx = np.arange(n_cmp)[:, None] * CMP_STRIDE + np.arange(CMP_BLOCK)[None, :]
    blocks = kv_cmp[:, idx]
    h = jnp.einsum('bnlsgd,slde->bnsge', blocks, w1) + (jnp.einsum('sld,slde->se', pe, w1) + b1)[:, None, :]
    h = jax.nn.silu(h)
    return jnp.einsum('bnsge,sef->bnsgf', h, w2) + b2[:, None, :]


def _cmp_attend(q, kc, vc, qpos):
    B, T = q.shape[:2]
    qg = q.reshape(B, T, N_KV_HEADS, N_HEADS // N_KV_HEADS, HEAD_DIM)
    ends = jnp.arange(kc.shape[1]) * CMP_STRIDE + CMP_BLOCK - 1
    s = jnp.einsum('btgrd,bngd->bgrtn', qg, kc, preferred_element_type=jnp.float32) * HEAD_DIM ** -0.5
    p = _masked_softmax(s, ends[None, :] <= qpos[:, None])
    o = jnp.einsum('bgrtn,bngd->btgrd', p.astype(vc.dtype), vc)
    return o.reshape(B, T, N_HEADS, HEAD_DIM), p


def _select_blocks(p_cmp, qpos, n_sel):
    n_cmp = p_cmp.shape[-1]
    ci = np.arange(n_cmp)[:, None] * CMP_STRIDE
    sj = np.arange(n_sel)[None, :] * SEL_BLOCK
    overlap = jnp.asarray(((ci < sj + SEL_BLOCK) & (ci + CMP_BLOCK > sj)).astype(np.float32))
    imp = jnp.einsum('bgtn,ns->bgts', jnp.sum(p_cmp, axis=2), overlap)
    j = jnp.arange(n_sel)[None, :]
    cur = (qpos // SEL_BLOCK)[:, None]
    allowed = j * SEL_BLOCK <= qpos[:, None]
    forced = (j == 0) | (j == cur) | (j == cur - 1)
    score = jnp.where(allowed, imp + jnp.where(forced, FORCE_BONUS, 0.0), NEG_INF)
    vals, idx = lax.top_k(score, min(N_SELECT, n_sel))
    return idx, vals > 0.5 * NEG_INF


def _select_attend(q, ks, vs, sel_idx, sel_valid, qpos):
    B, T = q.shape[:2]
    L = ks.shape[1]
    n_sel = -(-L // SEL_BLOCK)
    pad = ((0, 0), (0, n_sel * SEL_BLOCK - L), (0, 0), (0, 0))
    kb = jnp.pad(ks, pad).reshape(B, n_sel, SEL_BLOCK, N_KV_HEADS, HEAD_DIM).transpose(0, 3, 1, 2, 4)
    vb = jnp.pad(vs, pad).reshape(B, n_sel, SEL_BLOCK, N_KV_HEADS, HEAD_DIM).transpose(0, 3, 1, 2, 4)
    r = N_HEADS // N_KV_HEADS
    qg = q.reshape(B, T, N_KV_HEADS, r, HEAD_DIM)
    K = sel_idx.shape[-1]
    qb = _block_size(T, SEL_QROWS // B)
    bi = jnp.arange(B)[:, None, None, None]
    gi = jnp.arange(N_KV_HEADS)[None, :, None, None]
    offs = jnp.arange(SEL_BLOCK)

    def one_block(i):
        s0 = i * qb
        qi = lax.dynamic_slice_in_dim(qg, s0, qb, axis=1)
        ii = lax.dynamic_slice_in_dim(sel_idx, s0, qb, axis=2)
        vi = lax.dynamic_slice_in_dim(sel_valid, s0, qb, axis=2)
        pi = lax.dynamic_slice_in_dim(qpos, s0, qb)
        kg = kb[bi, gi, ii].reshape(B, N_KV_HEADS, qb, K * SEL_BLOCK, HEAD_DIM)
        vg = vb[bi, gi, ii].reshape(B, N_KV_HEADS, qb, K * SEL_BLOCK, HEAD_DIM)
        kpos = ii[..., None] * SEL_BLOCK + offs
        mask = (vi[..., None] & (kpos <= pi[None, None, :, None, None])).reshape(B, N_KV_HEADS, qb, K * SEL_BLOCK)
        s = jnp.einsum('bqgrd,bgqnd->bgrqn', qi, kg, preferred_element_type=jnp.float32) * HEAD_DIM ** -0.5
        p = _masked_softmax(s, mask[:, :, None])
        o = jnp.einsum('bgrqn,bgqnd->bqgrd', p.astype(vg.dtype), vg)
        return o.reshape(B, qb, N_HEADS, HEAD_DIM)

    out = lax.map(one_block, jnp.arange(T // qb))
    return jnp.moveaxis(out, 0, 1).reshape(B, T, N_HEADS, HEAD_DIM)


def _window_attend(q, kw, vw, kpos, qpos):
    B, T = q.shape[:2]
    r = N_HEADS // N_KV_HEADS
    qg = q.reshape(B, T, N_KV_HEADS, r, HEAD_DIM)
    qb = _block_size(T, WIN_QBLK)

    def one_block(i):
        s0 = i * qb
        qi = lax.dynamic_slice_in_dim(qg, s0, qb, axis=1)
        ki = lax.dynamic_slice_in_dim(kw, s0, WINDOW + qb, axis=1)
        vi = lax.dynamic_slice_in_dim(vw, s0, WINDOW + qb, axis=1)
        kp = lax.dynamic_slice_in_dim(kpos, s0, WINDOW + qb)
        qp = lax.dynamic_slice_in_dim(qpos, s0, qb)
        dist = qp[:, None] - kp[None, :]
        mask = (dist >= 0) & (dist <= WINDOW) & (kp >= 0)[None, :]
        s = jnp.einsum('bqgrd,bkgd->bgrqk', qi, ki, preferred_element_type=jnp.float32) * HEAD_DIM ** -0.5
        p = _masked_softmax(s, mask)
        o = jnp.einsum('bgrqk,bkgd->bqgrd', p.astype(vi.dtype), vi)
        return o.reshape(B, qb, N_HEADS, HEAD_DIM)

    out = lax.map(one_block, jnp.arange(T // qb))
    return jnp.moveaxis(out, 0, 1).reshape(B, T, N_HEADS, HEAD_DIM)


def _causal_depthwise_conv(u_all, w, b):
    y = lax.conv_general_dilated(u_all, w[:, None, :], window_strides=(1,), padding='VALID',
                                 dimension_numbers=('NWC', 'WIO', 'NWC'), feature_group_count=CONV_DIM)
    return y + b


def _layer(x, c, kv_past, win_past, conv_past, w_ada, b_ada, norm_pre, norm_post, w_in,
           cmp_pe, cmp_w1, cmp_b1, cmp_w2, cmp_b2, conv_dw, conv_db, conv_ln_g, conv_ln_b, w_out):
    B, T, _ = x.shape
    pos0 = kv_past.shape[1]
    pw = win_past.shape[1]
    shift, scale, gate = jnp.split(jax.nn.silu(c) @ w_ada + b_ada, 3, axis=-1)
    h = _rmsnorm(x, norm_pre) * (1.0 + scale[:, None, :]) + shift[:, None, :]
    proj = h @ w_in
    cuts = np.cumsum([Q_COLS, KV_COLS, WIN_COLS, GATE_COLS, NSA_WIDTH, 2 * CONV_DIM]).tolist()
    q, kv_new, win_new, g_raw, z_nsa, glu_in, z_conv = jnp.split(proj, cuts, axis=-1)
    q = q.reshape(B, T, N_HEADS, HEAD_DIM)
    kv_new = kv_new.reshape(B, T, N_CACHE_SLOTS, N_KV_HEADS, HEAD_DIM)
    win_new = win_new.reshape(B, T, N_WIN_SLOTS, N_KV_HEADS, HEAD_DIM)
    qpos = pos0 + jnp.arange(T)

    kv_full = jnp.concatenate([kv_past, kv_new], axis=1)
    kc = _compress(kv_full[:, :, 0:2], cmp_pe, cmp_w1, cmp_b1, cmp_w2, cmp_b2)
    o_cmp, p_cmp = _cmp_attend(q, kc[:, :, 0], kc[:, :, 1], qpos)
    n_sel = -(-kv_full.shape[1] // SEL_BLOCK)
    sel_idx, sel_valid = _select_blocks(p_cmp, qpos, n_sel)
    o_slc = _select_attend(q, kv_full[:, :, 2], kv_full[:, :, 3], sel_idx, sel_valid, qpos)
    win_all = jnp.concatenate([win_past, win_new], axis=1)
    win_pad = jnp.pad(win_all, ((0, 0), (WINDOW - pw, 0), (0, 0), (0, 0), (0, 0)))
    kpos = pos0 - WINDOW + jnp.arange(WINDOW + T)
    o_win = _window_attend(q, win_pad[:, :, 0], win_pad[:, :, 1], kpos, qpos)
    g = jax.nn.sigmoid(g_raw.reshape(B, T, N_BRANCH, N_HEADS))[..., None]
    o = g[:, :, 0] * o_cmp + g[:, :, 1] * o_slc + g[:, :, 2] * o_win
    o_nsa = o.reshape(B, T, NSA_WIDTH) * jax.nn.silu(z_nsa)

    a, gl = jnp.split(glu_in, 2, axis=-1)
    u = a * jax.nn.sigmoid(gl)
    u_all = jnp.concatenate([conv_past, u], axis=1)
    cv = _causal_depthwise_conv(u_all, conv_dw, conv_db)
    cv = jax.nn.silu(_layernorm(cv, conv_ln_g, conv_ln_b)) * jax.nn.silu(z_conv)

    mix = jnp.concatenate([o_nsa, cv], axis=-1) @ w_out
    y = x + gate[:, None, :] * _rmsnorm(mix, norm_post)
    keep = min(WINDOW, pw + T)
    new_win = win_all[:, pw + T - keep:]
    new_conv = u_all[:, u_all.shape[1] - (CONV_WIDTH - 1):]
    return y, kv_new, new_win, new_conv


def setup_inputs(seed: int = 0) -> dict:
    key = jax.random.key(seed)
    ks = jax.random.split(key, 24)
    f32 = jnp.float32
    n_pages = PAST_LEN // PAGE_SIZE
    n_phys = (5 * DEC_BATCH * n_pages) // 4
    w_len = min(WINDOW, PAST_LEN)

    def nrm(k, shape, s=1.0):
        return jax.random.normal(k, shape, f32) * s

    page_table = jax.random.permutation(ks[5], n_phys)[:DEC_BATCH * n_pages].reshape(DEC_BATCH, n_pages).astype(jnp.int32)
    return {
        'x_prompt': nrm(ks[0], (BATCH, SEQ, D_MODEL)),
        'x_sample': nrm(ks[1], (DEC_BATCH, DEC_SEQ, D_MODEL)),
        'c_prompt': nrm(ks[2], (BATCH, D_MODEL)),
        'c_sample': nrm(ks[3], (DEC_BATCH, D_MODEL)),
        'cache_kv': nrm(ks[4], (DEPTH, n_phys, PAGE_SIZE, N_CACHE_SLOTS, N_KV_HEADS, HEAD_DIM)),
        'page_table': page_table,
        'state_win_kv': nrm(ks[6], (DEPTH, DEC_BATCH, w_len, N_WIN_SLOTS, N_KV_HEADS, HEAD_DIM)),
        'state_conv': nrm(ks[7], (DEPTH, DEC_BATCH, CONV_WIDTH - 1, CONV_DIM), 0.5),
        'w_ada': nrm(ks[8], (DEPTH, D_MODEL, 3 * D_MODEL), 0.5 * D_MODEL ** -0.5),
        'b_ada': nrm(ks[9], (DEPTH, 3 * D_MODEL), 0.01),
        'norm_pre': 1.0 + nrm(ks[10], (DEPTH, D_MODEL), 0.01),
        'norm_post': 1.0 + nrm(ks[11], (DEPTH, D_MODEL), 0.01),
        'w_in': nrm(ks[12], (DEPTH, D_MODEL, IN_COLS), D_MODEL ** -0.5),
        'cmp_pe': nrm(ks[13], (DEPTH, 2, CMP_BLOCK, HEAD_DIM), 0.1),
        'cmp_w1': nrm(ks[14], (DEPTH, 2, CMP_BLOCK, HEAD_DIM, HEAD_DIM), (CMP_BLOCK * HEAD_DIM) ** -0.5),
        'cmp_b1': nrm(ks[15], (DEPTH, 2, HEAD_DIM), 0.01),
        'cmp_w2': nrm(ks[16], (DEPTH, 2, HEAD_DIM, HEAD_DIM), HEAD_DIM ** -0.5),
        'cmp_b2': nrm(ks[17], (DEPTH, 2, HEAD_DIM), 0.01),
        'conv_dw': nrm(ks[18], (DEPTH, CONV_WIDTH, CONV_DIM), CONV_WIDTH ** -0.5),
        'conv_db': nrm(ks[19], (DEPTH, CONV_DIM), 0.01),
        'conv_ln_g': 1.0 + nrm(ks[20], (DEPTH, CONV_DIM), 0.01),
        'conv_ln_b': nrm(ks[21], (DEPTH, CONV_DIM), 0.01),
        'w_out': nrm(ks[22], (DEPTH, MIX_WIDTH, D_MODEL), MIX_WIDTH ** -0.5),
    }


def reference(x_prompt, x_sample, c_prompt, c_sample, cache_kv, page_table, state_win_kv, state_conv,
              w_ada, b_ada, norm_pre, norm_post, w_in, cmp_pe, cmp_w1, cmp_b1, cmp_w2, cmp_b2,
              conv_dw, conv_db, conv_ln_g, conv_ln_b, w_out):
    bp = x_prompt.shape[0]
    bs, n_pages = page_table.shape
    past_len = n_pages * cache_kv.shape[2]
    hp, hs = x_prompt, x_sample
    kv_p, kv_s, win_p, win_s, conv_p, conv_s = [], [], [], [], [], []
    for l in range(DEPTH):
        wl = (w_ada[l], b_ada[l], norm_pre[l], norm_post[l], w_in[l], cmp_pe[l], cmp_w1[l], cmp_b1[l],
              cmp_w2[l], cmp_b2[l], conv_dw[l], conv_db[l], conv_ln_g[l], conv_ln_b[l], w_out[l])
        hp, a1, a2, a3 = _layer(
            hp, c_prompt,
            jnp.zeros((bp, 0, N_CACHE_SLOTS, N_KV_HEADS, HEAD_DIM), hp.dtype),
            jnp.zeros((bp, 0, N_WIN_SLOTS, N_KV_HEADS, HEAD_DIM), hp.dtype),
            jnp.zeros((bp, CONV_WIDTH - 1, CONV_DIM), hp.dtype), *wl)
        kv_past = cache_kv[l][page_table].reshape(bs, past_len, N_CACHE_SLOTS, N_KV_HEADS, HEAD_DIM)
        hs, b1_, b2_, b3_ = _layer(hs, c_sample, kv_past, state_win_kv[l], state_conv[l], *wl)
        kv_p.append(a1); win_p.append(a2); conv_p.append(a3)
        kv_s.append(b1_); win_s.append(b2_); conv_s.append(b3_)
    kv_rows_prompt = jnp.stack(kv_p)
    kv_rows_sample = jnp.stack(kv_s)
    win_prompt = jnp.stack(win_p)
    win_sample = jnp.stack(win_s)
    conv_prompt = jnp.stack(conv_p)
    conv_sample = jnp.stack(conv_s)
    return (hp, hs, kv_rows_prompt, kv_rows_sample, win_prompt, win_sample, conv_prompt, conv_sample)
```

```cpp
#ifndef CPU_TEST
#include <hip/hip_runtime.h>
#endif
#include <stdint.h>
#include <stddef.h>
#include <math.h>
#include <stdio.h>

#ifdef CPU_TEST
#define __device__
#define __host__
#define __forceinline__ inline
static inline float rsqrtf(float x) { return 1.0f / sqrtf(x); }
#endif

#ifndef CFG_BATCH
#define CFG_BATCH 4
#define CFG_SEQ 2048
#define CFG_DEC_BATCH 128
#define CFG_DEC_SEQ 4
#define CFG_PAST 2048
#endif
namespace cfg {
constexpr long al64(long x) { return (x + 63) & ~63L; }
constexpr int D = 2048, BATCH = CFG_BATCH, SEQ = CFG_SEQ, DEC_BATCH = CFG_DEC_BATCH, DEC_SEQ = CFG_DEC_SEQ, PAST = CFG_PAST, PAGE = 128;
constexpr int NPAGES = PAST / PAGE;
constexpr int HD = 128, NH = 8, NG = 2, NSA_W = 1024, CONV_C = 1024, WINDOW = 512, CONVW = 31;
constexpr int IN_COLS = 6680;
constexpr int C_Q = 0, C_KV = 1024, C_WIN = 2048, C_GATE = 2560, C_ZN = 2816, C_GL = 3840, C_ZC = 5888, LDP = 6912;
constexpr int TOK_P = BATCH * SEQ, TOK_S = DEC_BATCH * DEC_SEQ, TOK = TOK_P + TOK_S, NSEQ = BATCH + DEC_BATCH;
constexpr int PW = PAST < WINDOW ? PAST : WINDOW;
constexpr int L_P = SEQ, L_S = PAST + DEC_SEQ, LMAX = L_P > L_S ? L_P : L_S;
constexpr int NCMP_P = (L_P - 32) / 16 + 1, NCMP_S = (L_S - 32) / 16 + 1, NCMPX = NCMP_P > NCMP_S ? NCMP_P : NCMP_S;
constexpr int NSEL_P = (L_P + 63) / 64, NSEL_S = (L_S + 63) / 64, NSELX = NSEL_P > NSEL_S ? NSEL_P : NSEL_S;
constexpr int KEEP_P = SEQ < WINDOW ? SEQ : WINDOW, KEEP_S = (PW + DEC_SEQ) < WINDOW ? (PW + DEC_SEQ) : WINDOW;
constexpr int NWK = WINDOW + 1;
constexpr long O_YP = 0, O_YS = O_YP + (long)TOK_P * D, O_KVP = O_YS + (long)TOK_S * D, O_KVS = O_KVP + (long)TOK_P * 1024, O_WP = O_KVS + (long)TOK_S * 1024,
               O_WS = O_WP + (long)BATCH * KEEP_P * 512, O_CP = O_WS + (long)DEC_BATCH * KEEP_S * 512, O_CS = O_CP + (long)BATCH * 30 * 1024, O_END = O_CS + (long)DEC_BATCH * 30 * 1024;
constexpr long W_CTL = 0, W_MOD = 16384, W_RSTD = al64(W_MOD + (long)NSEQ * 6144), W_H = al64(W_RSTD + TOK), W_PROJ = al64(W_H + (long)TOK * D), W_HCMP = al64(W_PROJ + (long)TOK * LDP),
               W_KC = al64(W_HCMP + (long)NSEQ * NCMPX * 512), W_PC = al64(W_KC + (long)NSEQ * NCMPX * 512), W_OCMP = al64(W_PC + (long)TOK * 8 * NCMPX), W_IMP = al64(W_OCMP + (long)TOK * 1024),
               W_SEL = al64(W_IMP + (long)TOK * 2 * NSELX), W_SSLC = al64(W_SEL + (long)TOK * 4), W_OSLC = al64(W_SSLC + (long)TOK * 8 * LMAX), W_SWIN = al64(W_OSLC + (long)TOK * 1024),
               W_OWIN = al64(W_SWIN + (long)TOK * 8 * NWK), W_U = al64(W_OWIN + (long)TOK * 1024), W_CV = al64(W_U + (long)TOK * 1024), W_CVST = al64(W_CV + (long)TOK * 1024), W_MIX = al64(W_CVST + (long)TOK * 2),
               W_O2 = al64(W_MIX + (long)TOK * D), W_RSTD2 = al64(W_O2 + (long)TOK * D),
               W_H16 = al64(W_RSTD2 + TOK), W_MIX16 = al64(W_H16 + (long)TOK * D / 2), W_WTIN = al64(W_MIX16 + (long)TOK * D / 2), W_WTOUT = al64(W_WTIN + (long)LDP * D / 2),
               W_Q16 = al64(W_WTOUT + (long)D * D / 2), W_KVW16 = al64(W_Q16 + (long)TOK * 1024 / 2),
               W_WC16 = al64(W_KVW16 + (long)TOK * 1536 / 2), W_W2T16 = al64(W_WC16 + 2L * 256 * 2048 / 2), W_CCONST = al64(W_W2T16 + 2L * 128 * 128 / 2),
               W_CCPART = al64(W_CCONST + 256), W_MOD2 = al64(W_CCPART + 2 * 32 * 128), W_GATES = al64(W_MOD2 + (long)NSEQ * 6144), W_ZN16 = al64(W_GATES + (long)TOK * 32), W_ZC16 = al64(W_ZN16 + (long)TOK * 1024 / 2),
               W_END = al64(W_ZC16 + (long)TOK * 1024 / 2);
}
using namespace cfg;

struct Params {
    const float *x_p, *x_s, *c_p, *c_s, *cache; const int* ptab; const float *swin, *sconv, *w_ada, *b_ada, *npre, *npost, *w_in, *pe, *w1, *b1, *w2, *b2, *dw, *db, *lng, *lnb, *w_out;
    float* out; float* ws;
};

#define NEG_BIG (-1e30f)
__device__ __forceinline__ float silu_f(float x) { return x / (1.0f + expf(-x)); }
__device__ __forceinline__ float sigmoid_f(float x) { return 1.0f / (1.0f + expf(-x)); }

__device__ __forceinline__ void tokinfo(int tok, int& seq, int& t, int& pos0) {
    if (tok < TOK_P) { seq = tok / SEQ; t = tok % SEQ; pos0 = 0; }
    else { const int r = tok - TOK_P; seq = BATCH + r / DEC_SEQ; t = r % DEC_SEQ; pos0 = PAST; }
}
__device__ __forceinline__ int tok_of(int seq, int t) { return seq < BATCH ? seq * SEQ + t : TOK_P + (seq - BATCH) * DEC_SEQ + t; }
__device__ __forceinline__ const float* xrow(const Params& P, int tok) { return tok < TOK_P ? P.x_p + (long)tok * D : P.x_s + (long)(tok - TOK_P) * D; }
__device__ __forceinline__ const float* kvrow(const Params& P, int seq, int pos) {
    if (seq < BATCH) return P.ws + W_PROJ + (long)tok_of(seq, pos) * LDP + C_KV;
    if (pos < PAST) { const int b = seq - BATCH; const int pg = P.ptab[b * NPAGES + pos / PAGE]; return P.cache + ((long)pg * PAGE + pos % PAGE) * 1024; }
    return P.ws + W_PROJ + (long)tok_of(seq, pos - PAST) * LDP + C_KV;
}
__device__ __forceinline__ const float* winrow(const Params& P, int seq, int pos) {
    if (seq < BATCH) return P.ws + W_PROJ + (long)tok_of(seq, pos) * LDP + C_WIN;
    if (pos < PAST) { const int b = seq - BATCH; return P.swin + ((long)b * PW + (pos - (PAST - PW))) * 512; }
    return P.ws + W_PROJ + (long)tok_of(seq, pos - PAST) * LDP + C_WIN;
}
__device__ __forceinline__ float uall(const Params& P, int seq, int idx, int c) {
    if (idx < 30) return seq < BATCH ? 0.0f : P.sconv[((long)(seq - BATCH) * 30 + idx) * 1024 + c];
    return P.ws[W_U + (long)tok_of(seq, idx - 30) * 1024 + c];
}

__device__ __forceinline__ void it_mod(const Params& P, long i) {
    const int seq = (int)(i / 6144), j = (int)(i % 6144);
    const float* c = seq < BATCH ? P.c_p + (long)seq * D : P.c_s + (long)(seq - BATCH) * D;
    float acc = 0.f;
    for (int k = 0; k < D; ++k) acc += silu_f(c[k]) * P.w_ada[(long)k * 6144 + j];
    P.ws[W_MOD + i] = acc + P.b_ada[j];
}
__device__ __forceinline__ void it_rstd(const Params& P, long i) {
    const float* x = xrow(P, (int)i); float s = 0.f;
    for (int k = 0; k < D; ++k) s += x[k] * x[k];
    P.ws[W_RSTD + i] = rsqrtf(s * (1.0f / D) + 1e-6f);
}
__device__ __forceinline__ void it_h(const Params& P, long i) {
    const int tok = (int)(i / D), k = (int)(i % D); int seq, t, pos0; tokinfo(tok, seq, t, pos0);
    const float* mod = P.ws + W_MOD + (long)seq * 6144;
    P.ws[W_H + i] = xrow(P, tok)[k] * P.ws[W_RSTD + tok] * P.npre[k] * (1.0f + mod[D + k]) + mod[k];
}
__host__ __device__ __forceinline__ int proj_src_col(int n) {
    if (n < C_GATE) return n;
    if (n < C_ZN) return (n - C_GATE) < 24 ? 2560 + (n - C_GATE) : -1;
    if (n < C_GL) return 2584 + (n - C_ZN);
    if (n < C_ZC) { const int r = n - C_GL, tt = r >> 8, w = r & 255; return w < 128 ? 3608 + 128 * tt + w : 4632 + 128 * tt + (w - 128); }
    return 5656 + (n - C_ZC);
}
__device__ __forceinline__ void it_proj(const Params& P, long i) {
    const int tok = (int)(i / LDP), n = (int)(i % LDP), src = proj_src_col(n);
    const float* h = P.ws + W_H + (long)tok * D; float acc = 0.f;
    if (src >= 0) for (int k = 0; k < D; ++k) acc += h[k] * P.w_in[(long)k * IN_COLS + src];
    P.ws[W_PROJ + (long)tok * LDP + n] = acc;
}
__device__ __forceinline__ void it_out_kv(const Params& P, long i) {
    const int tok = (int)(i / 1024), c = (int)(i % 1024);
    P.out[(tok < TOK_P ? O_KVP + (long)tok * 1024 : O_KVS + (long)(tok - TOK_P) * 1024) + c] = P.ws[W_PROJ + (long)tok * LDP + C_KV + c];
}
__device__ __forceinline__ void it_out_win_p(const Params& P, long i) {
    const int c = (int)(i % 512); const long r = i / 512; const int ii = (int)(r % KEEP_P), b = (int)(r / KEEP_P);
    P.out[O_WP + i] = winrow(P, b, 0 + SEQ - KEEP_P + ii)[c];
}
__device__ __forceinline__ void it_out_win_s(const Params& P, long i) {
    const int c = (int)(i % 512); const long r = i / 512; const int ii = (int)(r % KEEP_S), b = (int)(r / KEEP_S);
    P.out[O_WS + i] = winrow(P, BATCH + b, PAST + DEC_SEQ - KEEP_S + ii)[c];
}
__device__ __forceinline__ void it_u(const Params& P, long i) {
    const int tok = (int)(i / 1024), c = (int)(i % 1024); const float* pr = P.ws + W_PROJ + (long)tok * LDP;
    P.ws[W_U + i] = pr[C_GL + 256 * (c >> 7) + (c & 127)] * sigmoid_f(pr[C_GL + 256 * (c >> 7) + 128 + (c & 127)]);
}
__device__ __forceinline__ void it_out_conv_p(const Params& P, long i) {
    const int c = (int)(i % 1024); const long r = i / 1024; const int ii = (int)(r % 30), b = (int)(r / 30);
    P.out[O_CP + i] = uall(P, b, SEQ + ii, c);
}
__device__ __forceinline__ void it_out_conv_s(const Params& P, long i) {
    const int c = (int)(i % 1024); const long r = i / 1024; const int ii = (int)(r % 30), b = (int)(r / 30);
    P.out[O_CS + i] = uall(P, BATCH + b, DEC_SEQ + ii, c);
}
__device__ __forceinline__ void it_hcmp(const Params& P, long i) {
    const int e = (int)(i % 128); long r = i / 128; const int sg = (int)(r % 4); r /= 4; const int n = (int)(r % NCMPX), seq = (int)(r / NCMPX);
    const int ncmp = seq < BATCH ? NCMP_P : NCMP_S; if (n >= ncmp) return;
    const int s = sg >> 1;
    float acc = P.b1[s * 128 + e];
    for (int l = 0; l < 32; ++l) {
        const float* kv = kvrow(P, seq, 16 * n + l) + sg * 128;
        const float* pe = P.pe + (s * 32 + l) * 128; const float* w = P.w1 + ((long)(s * 32 + l) * 128) * 128 + e;
        for (int d = 0; d < 128; ++d) acc += (kv[d] + pe[d]) * w[(long)d * 128];
    }
    P.ws[W_HCMP + i] = acc;
}
__device__ __forceinline__ void it_kc(const Params& P, long i) {
    const int f = (int)(i % 128); long r = i / 128; const int sg = (int)(r % 4); r /= 4; const int n = (int)(r % NCMPX), seq = (int)(r / NCMPX);
    const int ncmp = seq < BATCH ? NCMP_P : NCMP_S; if (n >= ncmp) return;
    const int s = sg >> 1; const float* h = P.ws + W_HCMP + (i - f);
    float acc = P.b2[s * 128 + f];
    for (int e = 0; e < 128; ++e) acc += silu_f(h[e]) * P.w2[((long)s * 128 + e) * 128 + f];
    P.ws[W_KC + i] = acc;
}
__device__ __forceinline__ void it_cmp_score(const Params& P, long i) {
    const int n = (int)(i % NCMPX); long r = i / NCMPX; const int h = (int)(r % 8), tok = (int)(r / 8); int seq, t, pos0; tokinfo(tok, seq, t, pos0);
    const int ncmp = seq < BATCH ? NCMP_P : NCMP_S, qpos = pos0 + t;
    float sc = NEG_BIG;
    if (n < ncmp && 16 * n + 31 <= qpos) {
        const float* q = P.ws + W_PROJ + (long)tok * LDP + C_Q + h * 128; const float* k = P.ws + W_KC + (((long)seq * NCMPX + n) * 4 + 0 * 2 + (h >> 2)) * 128;
        float acc = 0.f; for (int d = 0; d < 128; ++d) acc += q[d] * k[d];
        sc = acc * 0.08838834764831845f;
    }
    P.ws[W_PC + i] = sc;
}
__device__ __forceinline__ void softmax_row(float* s, int n) {
    float m = NEG_BIG; for (int j = 0; j < n; ++j) m = fmaxf(m, s[j]);
    float sum = 0.f; for (int j = 0; j < n; ++j) { const float v = s[j]; sum += (v > -0.5e30f) ? expf(v - m) : 0.f; }
    const float inv = 1.0f / fmaxf(sum, 1e-30f);
    for (int j = 0; j < n; ++j) { const float v = s[j]; s[j] = (v > -0.5e30f) ? expf(v - m) * inv : 0.f; }
}
__device__ __forceinline__ void it_cmp_softmax(const Params& P, long i) { softmax_row(P.ws + W_PC + i * NCMPX, NCMPX); }
__device__ __forceinline__ void it_ocmp(const Params& P, long i) {
    const int c = (int)(i % 1024), tok = (int)(i / 1024), h = c >> 7, d = c & 127; int seq, t, pos0; tokinfo(tok, seq, t, pos0);
    const int ncmp = seq < BATCH ? NCMP_P : NCMP_S; const float* p = P.ws + W_PC + ((long)tok * 8 + h) * NCMPX;
    float acc = 0.f;
    for (int n = 0; n < ncmp; ++n) acc += p[n] * P.ws[W_KC + (((long)seq * NCMPX + n) * 4 + 1 * 2 + (h >> 2)) * 128 + d];
    P.ws[W_OCMP + i] = acc;
}
__device__ __forceinline__ void it_imp(const Params& P, long i) {
    const int j = (int)(i % NSELX); long r = i / NSELX; const int g = (int)(r % 2), tok = (int)(r / 2); int seq, t, pos0; tokinfo(tok, seq, t, pos0);
    const int ncmp = seq < BATCH ? NCMP_P : NCMP_S;
    int n0 = 4 * j - 1; if (n0 < 0) n0 = 0; int n1 = 4 * j + 3; if (n1 > ncmp - 1) n1 = ncmp - 1;
    float acc = 0.f;
    for (int n = n0; n <= n1; ++n) { float s4 = 0.f; for (int rr = 0; rr < 4; ++rr) s4 += P.ws[W_PC + ((long)tok * 8 + g * 4 + rr) * NCMPX + n]; acc += s4; }
    P.ws[W_IMP + i] = acc;
}
__device__ __forceinline__ void it_select(const Params& P, long i) {
    const int g = (int)(i % 2), tok = (int)(i / 2); int seq, t, pos0; tokinfo(tok, seq, t, pos0);
    const int nsel = seq < BATCH ? NSEL_P : NSEL_S, qpos = pos0 + t, cur = qpos / 64;
    const float* imp = P.ws + W_IMP + ((long)tok * 2 + g) * NSELX;
    unsigned long long chosen = 0ull;
    const int K = nsel < 16 ? nsel : 16;
    for (int it = 0; it < K; ++it) {
        float best = -3e38f; int bj = -1;
        for (int j = 0; j < nsel; ++j) {
            if ((chosen >> j) & 1ull) continue;
            const bool allowed = j * 64 <= qpos; const bool forced = (j == 0) || (j == cur) || (j == cur - 1);
            const float sc = allowed ? imp[j] + (forced ? 1e6f : 0.0f) : NEG_BIG;
            if (sc > best) { best = sc; bj = j; }
        }
        if (bj < 0 || !(best > -0.5e30f)) break;
        chosen |= 1ull << bj;
    }
    unsigned* o = (unsigned*)(P.ws + W_SEL) + ((long)tok * 2 + g) * 2;
    o[0] = (unsigned)chosen; o[1] = (unsigned)(chosen >> 32);
}
__device__ __forceinline__ void it_slc_score(const Params& P, long i) {
    const int pos = (int)(i % LMAX); long r = i / LMAX; const int h = (int)(r % 8), tok = (int)(r / 8); int seq, t, pos0; tokinfo(tok, seq, t, pos0);
    const int qpos = pos0 + t, g = h >> 2;
    const unsigned* sm = (const unsigned*)(P.ws + W_SEL) + ((long)tok * 2 + g) * 2;
    const unsigned long long mask = (unsigned long long)sm[0] | ((unsigned long long)sm[1] << 32);
    float sc = NEG_BIG;
    if (pos <= qpos && ((mask >> (pos >> 6)) & 1ull)) {
        const float* q = P.ws + W_PROJ + (long)tok * LDP + C_Q + h * 128; const float* k = kvrow(P, seq, pos) + (2 * 2 + g) * 128;
        float acc = 0.f; for (int d = 0; d < 128; ++d) acc += q[d] * k[d];
        sc = acc * 0.08838834764831845f;
    }
    P.ws[W_SSLC + i] = sc;
}
__device__ __forceinline__ void it_slc_softmax(const Params& P, long i) {
    const int tok = (int)(i / 8); int seq, t, pos0; tokinfo(tok, seq, t, pos0);
    softmax_row(P.ws + W_SSLC + i * LMAX, pos0 + t + 1);
}
__device__ __forceinline__ void it_oslc(const Params& P, long i) {
    const int c = (int)(i % 1024), tok = (int)(i / 1024), h = c >> 7, d = c & 127; int seq, t, pos0; tokinfo(tok, seq, t, pos0);
    const int qpos = pos0 + t, g = h >> 2; const float* p = P.ws + W_SSLC + ((long)tok * 8 + h) * LMAX;
    float acc = 0.f;
    for (int pos = 0; pos <= qpos; ++pos) { const float pv = p[pos]; if (pv != 0.f) acc += pv * kvrow(P, seq, pos)[(3 * 2 + g) * 128 + d]; }
    P.ws[W_OSLC + i] = acc;
}
__device__ __forceinline__ void it_win_score(const Params& P, long i) {
    const int w = (int)(i % NWK); long r = i / NWK; const int h = (int)(r % 8), tok = (int)(r / 8); int seq, t, pos0; tokinfo(tok, seq, t, pos0);
    const int qpos = pos0 + t, g = h >> 2, pos = qpos - WINDOW + w;
    float sc = NEG_BIG;
    if (pos >= 0 && pos >= pos0 - PW) {
        const float* q = P.ws + W_PROJ + (long)tok * LDP + C_Q + h * 128; const float* k = winrow(P, seq, pos) + (0 * 2 + g) * 128;
        float acc = 0.f; for (int d = 0; d < 128; ++d) acc += q[d] * k[d];
        sc = acc * 0.08838834764831845f;
    }
    P.ws[W_SWIN + i] = sc;
}
__device__ __forceinline__ void it_win_softmax(const Params& P, long i) { softmax_row(P.ws + W_SWIN + i * NWK, NWK); }
__device__ __forceinline__ void it_owin(const Params& P, long i) {
    const int c = (int)(i % 1024), tok = (int)(i / 1024), h = c >> 7, d = c & 127; int seq, t, pos0; tokinfo(tok, seq, t, pos0);
    const int qpos = pos0 + t, g = h >> 2; const float* p = P.ws + W_SWIN + ((long)tok * 8 + h) * NWK;
    float acc = 0.f;
    for (int w = 0; w < NWK; ++w) { const float pv = p[w]; if (pv != 0.f) acc += pv * winrow(P, seq, qpos - WINDOW + w)[(1 * 2 + g) * 128 + d]; }
    P.ws[W_OWIN + i] = acc;
}
__device__ __forceinline__ void it_combine(const Params& P, long i) {
    const int c = (int)(i % 1024), tok = (int)(i / 1024), h = c >> 7; const float* pr = P.ws + W_PROJ + (long)tok * LDP;
    const float g0 = sigmoid_f(pr[C_GATE + 0 * 8 + h]), g1 = sigmoid_f(pr[C_GATE + 1 * 8 + h]), g2 = sigmoid_f(pr[C_GATE + 2 * 8 + h]);
    const float o = g0 * P.ws[W_OCMP + i] + g1 * P.ws[W_OSLC + i] + g2 * P.ws[W_OWIN + i];
    const float mv = o * silu_f(pr[C_ZN + c]);
    P.ws[W_MIX + (long)tok * D + c] = mv;
#ifndef CPU_TEST
    ((_Float16*)(P.ws + W_MIX16))[(long)tok * D + c] = (_Float16)mv;
#endif
}
__device__ __forceinline__ void it_cv(const Params& P, long i) {
    const int c = (int)(i % 1024), tok = (int)(i / 1024); int seq, t, pos0; tokinfo(tok, seq, t, pos0);
    float acc = P.db[c];
    for (int k = 0; k < CONVW; ++k) acc += P.dw[k * 1024 + c] * uall(P, seq, t + k, c);
    P.ws[W_CV + i] = acc;
}
__device__ __forceinline__ void it_cvstat(const Params& P, long i) {
    const float* cv = P.ws + W_CV + i * 1024; float s = 0.f; for (int c = 0; c < 1024; ++c) s += cv[c];
    const float mu = s * (1.0f / 1024); float v = 0.f; for (int c = 0; c < 1024; ++c) { const float d = cv[c] - mu; v += d * d; }
    P.ws[W_CVST + i * 2] = mu; P.ws[W_CVST + i * 2 + 1] = rsqrtf(v * (1.0f / 1024) + 1e-6f);
}
__device__ __forceinline__ void it_mixconv(const Params& P, long i) {
    const int c = (int)(i % 1024), tok = (int)(i / 1024);
    const float ln = (P.ws[W_CV + i] - P.ws[W_CVST + tok * 2]) * P.ws[W_CVST + tok * 2 + 1] * P.lng[c] + P.lnb[c];
    const float mv = silu_f(ln) * silu_f(P.ws[W_PROJ + (long)tok * LDP + C_ZC + c]);
    P.ws[W_MIX + (long)tok * D + 1024 + c] = mv;
#ifndef CPU_TEST
    ((_Float16*)(P.ws + W_MIX16))[(long)tok * D + 1024 + c] = (_Float16)mv;
#endif
}
__device__ __forceinline__ void it_o2(const Params& P, long i) {
    const int tok = (int)(i / D), n = (int)(i % D); const float* m = P.ws + W_MIX + (long)tok * D; float acc = 0.f;
    for (int k = 0; k < D; ++k) acc += m[k] * P.w_out[(long)k * D + n];
    P.ws[W_O2 + i] = acc;
}
__device__ __forceinline__ void it_rstd2(const Params& P, long i) {
    const float* x = P.ws + W_O2 + i * D; float s = 0.f; for (int k = 0; k < D; ++k) s += x[k] * x[k];
    P.ws[W_RSTD2 + i] = rsqrtf(s * (1.0f / D) + 1e-6f);
}
__device__ __forceinline__ void it_y(const Params& P, long i) {
    const int tok = (int)(i / D), n = (int)(i % D); int seq, t, pos0; tokinfo(tok, seq, t, pos0);
    const float gate = P.ws[W_MOD + (long)seq * 6144 + 2 * D + n];
    const float y = xrow(P, tok)[n] + gate * (P.ws[W_O2 + i] * P.ws[W_RSTD2 + tok] * P.npost[n]);
    P.out[(tok < TOK_P ? O_YP + (long)tok * D : O_YS + (long)(tok - TOK_P) * D) + n] = y;
}

#ifndef CPU_TEST
__device__ __forceinline__ void it_wc16(const Params& P, long i) {
    const int k = (int)(i % 2048), n = (int)((i / 2048) % 256), s = (int)(i / (2048 * 256)), lp = k >> 7, d = k & 127, l = n < 128 ? lp : 16 + lp, e = n & 127;
    ((_Float16*)(P.ws + W_WC16))[i] = (_Float16)P.w1[(((long)s * 32 + l) * 128 + d) * 128 + e];
}
__device__ __forceinline__ void it_w2t16(const Params& P, long i) {
    const int e = (int)(i % 128), f = (int)((i / 128) % 128), s = (int)(i / (128 * 128));
    ((_Float16*)(P.ws + W_W2T16))[i] = (_Float16)P.w2[((long)s * 128 + e) * 128 + f];
}
__device__ __forceinline__ void it_cconst_part(const Params& P, long i) {
    const int e = (int)(i & 127), ch = (int)((i >> 7) & 31), s = (int)(i >> 12); float acc = 0.f;
    for (int q = 0; q < 128; ++q) { const int ld = ch * 128 + q; acc += P.pe[s * 4096 + ld] * P.w1[((long)s * 4096 + ld) * 128 + e]; }
    P.ws[W_CCPART + i] = acc;
}
__device__ __forceinline__ void it_cconst_fin(const Params& P, long i) {
    const int e = (int)(i & 127), s = (int)(i >> 7); float acc = P.b1[i];
    for (int ch = 0; ch < 32; ++ch) acc += P.ws[W_CCPART + ((long)(s * 32 + ch) << 7) + e];
    P.ws[W_CCONST + i] = acc;
}
__device__ __forceinline__ void it_copy_win_state(const Params& P, long i) {
    typedef float f4 __attribute__((ext_vector_type(4)));
    constexpr long PER = (long)(KEEP_S - DEC_SEQ) * 128; const long b = i / PER, r = i % PER;
    ((f4*)(P.out + O_WS + b * KEEP_S * 512))[r] = ((const f4*)(P.swin + (b * PW + (PW + DEC_SEQ - KEEP_S)) * 512))[r];
}
__device__ __forceinline__ void it_copy_conv_state(const Params& P, long i) {
    typedef float f4 __attribute__((ext_vector_type(4)));
    constexpr long PER = (long)(30 - DEC_SEQ) * 256; const long b = i / PER, r = i % PER;
    ((f4*)(P.out + O_CS + b * 30 * 1024))[r] = ((const f4*)(P.sconv + (b * 30 + DEC_SEQ) * 1024))[r];
}
__device__ __forceinline__ void it_out_win_s_new(const Params& P, long i) {
    const int c = (int)(i % 512); const long r = i / 512; const int t = (int)(r % DEC_SEQ), b = (int)(r / DEC_SEQ);
    P.out[O_WS + ((long)b * KEEP_S + (KEEP_S - DEC_SEQ) + t) * 512 + c] = P.ws[W_PROJ + (long)tok_of(BATCH + b, t) * LDP + C_WIN + c];
}
__device__ __forceinline__ void it_out_conv_s_new(const Params& P, long i) {
    const int c = (int)(i % 1024); const long r = i / 1024; const int t = (int)(r % DEC_SEQ), b = (int)(r / DEC_SEQ);
    P.out[O_CS + ((long)b * 30 + (30 - DEC_SEQ) + t) * 1024 + c] = P.ws[W_U + (long)tok_of(BATCH + b, t) * 1024 + c];
}
__device__ __forceinline__ void it_cvt_q(const Params& P, long i) { const long tok = i / 1024; const int c = (int)(i % 1024); ((_Float16*)(P.ws + W_Q16))[i] = (_Float16)P.ws[W_PROJ + tok * LDP + C_Q + c]; }
__device__ __forceinline__ void it_cvt_kvw(const Params& P, long i) { const long tok = i / 1536; const int c = (int)(i % 1536); ((_Float16*)(P.ws + W_KVW16))[i] = (_Float16)P.ws[W_PROJ + tok * LDP + C_KV + c]; }
#endif
#define N_PHASES 16
#ifdef CPU_TEST
#define ATT_TOK0 0
#define NAIVE_CMP(x) x
#define NAIVE_ROW(x) x
#define WAVE_ROWS(fn)
#else
#define ATT_TOK0 TOK_P
#define NAIVE_CMP(x)
#define NAIVE_ROW(x)
#define WAVE_ROWS(fn) { const int t_ = OTID(), lane_ = t_ & 63, gw_ = blockIdx.x * NWAVES + __builtin_amdgcn_readfirstlane(t_ >> 6); for (int tok_ = gw_; tok_ < TOK; tok_ += G * NWAVES) fn(P, tok_, lane_); }
#endif
#define PHASE_BODY(ph)                                                                                                                   \
    if (ph == 0) { RUN((long)NSEQ * 6144, it_mod); RUN((long)TOK, it_rstd); }                                                            \
    if (ph == 1) { RUN((long)TOK * D, it_h); }                                                                                           \
    if (ph == 2) { RUN((long)TOK * LDP, it_proj); }                                                                                  \
    if (ph == 3) { NAIVE_CMP(RUN((long)NSEQ * NCMPX * 512, it_hcmp)); RUN((long)TOK * 1024, it_u); RUN_OFF((long)(TOK - ATT_TOK0) * 8 * NWK, (long)ATT_TOK0 * 8 * NWK, it_win_score);          \
                   RUN((long)TOK * 1024, it_out_kv); RUN((long)BATCH * KEEP_P * 512, it_out_win_p); RUN((long)DEC_BATCH * KEEP_S * 512, it_out_win_s); } \
    if (ph == 4) { NAIVE_CMP(RUN((long)NSEQ * NCMPX * 512, it_kc)); RUN((long)TOK * 1024, it_cv); RUN_OFF((long)(TOK - ATT_TOK0) * 8, (long)ATT_TOK0 * 8, it_win_softmax);               \
                   RUN((long)BATCH * 30 * 1024, it_out_conv_p); RUN((long)DEC_BATCH * 30 * 1024, it_out_conv_s); }                       \
    if (ph == 5) { RUN((long)TOK * 8 * NCMPX, it_cmp_score); NAIVE_ROW(RUN((long)TOK, it_cvstat)); RUN_OFF((long)(TOK - ATT_TOK0) * 1024, (long)ATT_TOK0 * 1024, it_owin); }                \
    if (ph == 6) { RUN((long)TOK * 8, it_cmp_softmax); NAIVE_ROW(RUN((long)TOK * 1024, it_mixconv)); WAVE_ROWS(mixconv_row); }                                              \
    if (ph == 7) { RUN((long)TOK * 1024, it_ocmp); RUN((long)TOK * 2 * NSELX, it_imp); }                                                 \
    if (ph == 8) { RUN((long)TOK * 2, it_select); }                                                                                      \
    if (ph == 9) { RUN_OFF((long)(TOK - ATT_TOK0) * 8 * LMAX, (long)ATT_TOK0 * 8 * LMAX, it_slc_score); }                                                                            \
    if (ph == 10) { RUN_OFF((long)(TOK - ATT_TOK0) * 8, (long)ATT_TOK0 * 8, it_slc_softmax); }                                                                                \
    if (ph == 11) { RUN_OFF((long)(TOK - ATT_TOK0) * 1024, (long)ATT_TOK0 * 1024, it_oslc); }                                                                                    \
    if (ph == 12) { RUN((long)TOK * 1024, it_combine); }                                                                                 \
    if (ph == 13) { RUN((long)TOK * D, it_o2); }                                                                                         \
    if (ph == 14) { RUN((long)TOK, it_rstd2); }                                                                                          \
    if (ph == 15) { RUN((long)TOK * D, it_y); }

#ifdef CPU_TEST
static void cpu_run_all(const Params& P) {
    for (int ph = 0; ph < N_PHASES; ++ph) {
#define RUN(n, fn) { const long _n = (n); _Pragma("omp parallel for schedule(static, 4096)") for (long _i = 0; _i < _n; ++_i) fn(P, _i); }
#define RUN_OFF(n, off, fn) { const long _n = (n), _o = (off); _Pragma("omp parallel for schedule(static, 4096)") for (long _i = 0; _i < _n; ++_i) fn(P, _i + _o); }
        PHASE_BODY(ph)
#undef RUN
#undef RUN_OFF
        fprintf(stderr, "phase %d done\n", ph);
    }
}
#else
#define LAS __attribute__((address_space(3)))
namespace pg8 {
#define PG8_LAS __attribute__((address_space(3)))
typedef unsigned short bf16_t;
typedef _Float16 bf16x8 __attribute__((ext_vector_type(8)));
typedef float f32x4 __attribute__((ext_vector_type(4)));
typedef unsigned u32x4 __attribute__((ext_vector_type(4)));
constexpr int BM = 256, BK = 64, HALF = 128, HTB = HALF * BK * 2  , STAGE_BYTES = 8 * HTB, NXCD = 8, WGM = 8;

__host__ __device__ __forceinline__ int lds_byte(int r, int c) { const int st = (r >> 4) * 2 + (c >> 5), rr = r & 15, cc = c & 31, ob = rr * 64 + cc * 2; return st * 1024 + (ob ^ (((ob >> 9) & 1) << 5)); }
__host__ __device__ __forceinline__ void stage_rc(int b, int& R, int& C) { const int st = b / 1024, sb = b % 1024, swz = sb ^ (((sb >> 9) & 1) << 5); R = (st >> 1) * 16 + swz / 64; C = (st & 1) * 32 + (swz % 64) / 2; }
__host__ __device__ __forceinline__ int perm32(int rho) { const int n = rho >> 4, i = rho & 15; return 8 * (i >> 2) + 4 * n + (i & 3); }

struct Unit { int pm, pn; };
struct Gemm { const bf16_t* A; const bf16_t* Bt; int M, N, K; };

struct StaticOrder {
    int nM, nN, nwg, G, c;
    __host__ __device__ void init(int M, int N, int G_, int c_) { nM = M / BM; nN = N / BM; nwg = nM * nN; G = G_; c = c_; }
    __host__ __device__ bool next(int i, Unit& u) const {
        const long L = (long)i * G + c; if (L >= nwg) return false;
        int wgid = (int)L; { const int q = nwg / NXCD, r = nwg % NXCD, xcd = wgid % NXCD, off = wgid / NXCD; wgid = (xcd < r ? xcd * (q + 1) : r * (q + 1) + (xcd - r) * q) + off; }
        const int nig = WGM * nN, gid = wgid / nig, fm = gid * WGM, gsz = (nM - fm) < WGM ? (nM - fm) : WGM;
        u.pm = fm + ((wgid % nig) % gsz); u.pn = (wgid % nig) / gsz; return true;
    }
    __device__ __forceinline__ void a_ready(const Unit&) const {}
    __device__ __forceinline__ void done(const Unit&) const {}
};
template <class Epi, class Sched, bool ALIGN_EPI = false, bool SP2 = false>
__device__ __forceinline__ void gemm_phase(PG8_LAS unsigned char* lds, const Gemm g, const Sched& S, const Epi& E) {
    int tid = threadIdx.x; asm volatile("" : "+v"(tid));
    const int wid = __builtin_amdgcn_readfirstlane(tid >> 6), lane = tid & 63, wr = wid >> 2, wc = wid & 3, fr = lane & 15, fq = lane >> 4;
    const int K = g.K, nt = K / BK;
    unsigned voffA[2], voffB[2];
#pragma unroll
    for (int i = 0; i < 2; ++i) { int R, C; stage_rc(tid * 16 + i * 8192, R, C); const int Rb = Epi::PERM ? ((R & ~31) + perm32(R & 31)) : R;
        voffA[i] = (unsigned)(R * K + C) * 2u; voffB[i] = (unsigned)(Rb * K + C) * 2u; }
    const size_t kstep = (size_t)(BK * 2);
    const size_t hstep = (size_t)HALF * K * 2;
    const size_t tstep = 2 * hstep;
    const unsigned ldsw = (unsigned)wid * 1024u;
    const int aoff = lds_byte(wr * 64 + fr, fq * 8), boff = lds_byte(wc * 32 + fr, fq * 8);
#define PG8_SA(b, h) (((b) * 2 + (h)) * HTB)
#define PG8_SB(b, h) ((4 + (b) * 2 + (h)) * HTB)
#define PG8_STAGE(bufoff, gbase, voff) do { _Pragma("unroll") for (int _i = 0; _i < 2; ++_i) \
        __builtin_amdgcn_global_load_lds((const unsigned*)((const char*)(gbase) + (voff)[_i]), (PG8_LAS unsigned*)(lds + (bufoff) + ldsw + _i * 8192), 16, 0, 0); } while (0)
#define PG8_LDA(dst, b, h) do { _Pragma("unroll") for (int m = 0; m < 4; ++m) _Pragma("unroll") for (int k = 0; k < 2; ++k) dst[m][k] = *(const PG8_LAS bf16x8*)(lds + PG8_SA(b, h) + aoff + m * 2048 + k * 1024); } while (0)
#define PG8_LDB(dst, b, h) do { _Pragma("unroll") for (int n = 0; n < 2; ++n) _Pragma("unroll") for (int k = 0; k < 2; ++k) dst[n][k] = *(const PG8_LAS bf16x8*)(lds + PG8_SB(b, h) + boff + n * 2048 + k * 1024); } while (0)
#define PG8_MMA(ai, bj, At, Bt) do { __builtin_amdgcn_s_setprio(1); _Pragma("unroll") for (int m = 0; m < 4; ++m) _Pragma("unroll") for (int n = 0; n < 2; ++n) _Pragma("unroll") for (int k = 0; k < 2; ++k) \
        acc[ai][bj][m][n] = __builtin_amdgcn_mfma_f32_16x16x32_f16(Bt[n][k], At[m][k], acc[ai][bj][m][n], 0, 0, 0); __builtin_amdgcn_s_setprio(0); } while (0)
#define PG8_WAIT_V(n) asm volatile("s_waitcnt vmcnt(" #n ")" ::: "memory")
#define PG8_WAIT_L(n) asm volatile("s_waitcnt lgkmcnt(" #n ")" ::: "memory")
#define PG8_BAR __builtin_amdgcn_s_barrier()
#define PG8_SCHED __builtin_amdgcn_sched_barrier(0)
    Unit cur, nxt; int ui = 0;
    if (!S.next(0, cur)) return;
    f32x4 acc[2][2][4][2];
#pragma unroll
    for (int a = 0; a < 2; ++a)
#pragma unroll
        for (int b = 0; b < 2; ++b)
#pragma unroll
            for (int m = 0; m < 4; ++m)
#pragma unroll
                for (int n = 0; n < 2; ++n) acc[a][b][m][n] = (f32x4){0.f, 0.f, 0.f, 0.f};
    bf16x8 At[4][2], B0[2][2], B1[2][2];
    const char* cA = (const char*)g.A + (size_t)cur.pm * tstep; const char* cB = (const char*)g.Bt + (size_t)cur.pn * tstep;
    S.a_ready(cur);
    if constexpr (SP2) {
        PG8_STAGE(PG8_SB(0, 0), cB, voffB); PG8_STAGE(PG8_SB(0, 1), cB + hstep, voffB); PG8_STAGE(PG8_SA(0, 0), cA, voffA); PG8_STAGE(PG8_SA(0, 1), cA + hstep, voffA);
        if (wr == 1) PG8_BAR;
        PG8_WAIT_V(2); PG8_BAR;
        PG8_STAGE(PG8_SB(1, 0), cB + kstep, voffB); PG8_STAGE(PG8_SA(1, 0), cA + kstep, voffA); PG8_STAGE(PG8_SB(1, 1), cB + hstep + kstep, voffB);
        PG8_WAIT_V(6); PG8_BAR;
    } else {
        PG8_STAGE(PG8_SB(0, 0), cB, voffB); PG8_STAGE(PG8_SA(0, 0), cA, voffA); PG8_STAGE(PG8_SB(0, 1), cB + hstep, voffB); PG8_STAGE(PG8_SA(0, 1), cA + hstep, voffA);
        if (wr == 1) PG8_BAR;
        PG8_WAIT_V(4); PG8_BAR;
        PG8_STAGE(PG8_SB(1, 0), cB + kstep, voffB); PG8_STAGE(PG8_SA(1, 0), cA + kstep, voffA); PG8_STAGE(PG8_SB(1, 1), cB + hstep + kstep, voffB);
        PG8_WAIT_V(6); PG8_BAR;
    }
    for (;;) {
        const bool has_next = S.next(ui + 1, nxt);
        const char* nA = has_next ? (const char*)g.A + (size_t)nxt.pm * tstep : cA; const char* nB = has_next ? (const char*)g.Bt + (size_t)nxt.pn * tstep : cB;
        for (int t = 0; t < nt; t += 2) {
            const bool last = (t == nt - 2);
            const char* a1 = cA + (size_t)(t + 1) * kstep;
            const char* a2 = last ? nA : cA + (size_t)(t + 2) * kstep; const char* b2 = last ? nB : cB + (size_t)(t + 2) * kstep;
            const char* a3 = a2 + kstep; const char* b3 = b2 + kstep;
            if (last && has_next) S.a_ready(nxt);
            if constexpr (SP2) {
            PG8_LDB(B0, 0, 0); PG8_LDB(B1, 0, 1); PG8_SCHED; PG8_LDA(At, 0, 0); PG8_STAGE(PG8_SA(1, 1), a1 + hstep, voffA);
            PG8_WAIT_V(8); PG8_WAIT_L(0); PG8_BAR; PG8_MMA(0, 0, At, B0); PG8_MMA(0, 1, At, B1); PG8_BAR; PG8_SCHED;
            PG8_LDA(At, 0, 1); PG8_STAGE(PG8_SB(0, 0), b2, voffB); PG8_STAGE(PG8_SB(0, 1), b2 + hstep, voffB); PG8_STAGE(PG8_SA(0, 0), a2, voffA);
            PG8_WAIT_V(8); PG8_WAIT_L(0); PG8_BAR; PG8_MMA(1, 0, At, B0); PG8_MMA(1, 1, At, B1); PG8_BAR; PG8_SCHED;
            PG8_LDB(B0, 1, 0); PG8_LDB(B1, 1, 1); PG8_SCHED; PG8_LDA(At, 1, 0); PG8_STAGE(PG8_SA(0, 1), a2 + hstep, voffA);
            PG8_WAIT_V(8); PG8_WAIT_L(0); PG8_BAR; PG8_MMA(0, 0, At, B0); PG8_MMA(0, 1, At, B1); PG8_BAR; PG8_SCHED;
            PG8_LDA(At, 1, 1); PG8_STAGE(PG8_SB(1, 0), b3, voffB); PG8_STAGE(PG8_SB(1, 1), b3 + hstep, voffB); PG8_STAGE(PG8_SA(1, 0), a3, voffA);
            PG8_WAIT_V(8); PG8_WAIT_L(0); PG8_BAR; PG8_MMA(1, 0, At, B0); PG8_MMA(1, 1, At, B1); PG8_BAR; PG8_SCHED;
            } else {
            PG8_LDB(B0, 0, 0); PG8_SCHED; PG8_LDA(At, 0, 0); PG8_STAGE(PG8_SA(1, 1), a1 + hstep, voffA);
            PG8_WAIT_L(8); PG8_BAR; PG8_WAIT_L(0); PG8_MMA(0, 0, At, B0); PG8_BAR; PG8_SCHED;
            PG8_LDB(B1, 0, 1); PG8_STAGE(PG8_SB(0, 0), b2, voffB);
            PG8_BAR; PG8_WAIT_L(0); PG8_MMA(0, 1, At, B1); PG8_BAR;
            PG8_LDA(At, 0, 1); PG8_STAGE(PG8_SA(0, 0), a2, voffA);
            PG8_BAR; PG8_WAIT_L(0); PG8_MMA(1, 0, At, B0); PG8_BAR; PG8_SCHED;
            PG8_STAGE(PG8_SB(0, 1), b2 + hstep, voffB);
            PG8_WAIT_V(6); PG8_BAR; PG8_MMA(1, 1, At, B1); PG8_BAR;
            PG8_LDB(B0, 1, 0); PG8_SCHED; PG8_LDA(At, 1, 0); PG8_STAGE(PG8_SA(0, 1), a2 + hstep, voffA);
            PG8_WAIT_L(8); PG8_BAR; PG8_WAIT_L(0); PG8_MMA(0, 0, At, B0); PG8_BAR; PG8_SCHED;
            PG8_LDB(B1, 1, 1); PG8_STAGE(PG8_SB(1, 0), b3, voffB);
            PG8_BAR; PG8_WAIT_L(0); PG8_MMA(0, 1, At, B1); PG8_BAR;
            PG8_LDA(At, 1, 1); PG8_STAGE(PG8_SA(1, 0), a3, voffA);
            PG8_BAR; PG8_WAIT_L(0); PG8_MMA(1, 0, At, B0); PG8_BAR; PG8_SCHED;
            PG8_STAGE(PG8_SB(1, 1), b3 + hstep, voffB);
            PG8_WAIT_V(6); PG8_BAR; PG8_MMA(1, 1, At, B1); PG8_BAR;
            }
        }
        if constexpr (ALIGN_EPI) { if (wr == 0) PG8_BAR; }
        if constexpr (!Epi::AFTER_DRAIN) { E(acc, cur, wr, wc, fr, fq); S.done(cur); }
        if (!has_next) break;
#pragma unroll
        for (int a = 0; a < 2; ++a)
#pragma unroll
            for (int b = 0; b < 2; ++b)
#pragma unroll
                for (int m = 0; m < 4; ++m)
#pragma unroll
                    for (int n = 0; n < 2; ++n) acc[a][b][m][n] = (f32x4){0.f, 0.f, 0.f, 0.f};
        cur = nxt; cA = nA; cB = nB; ++ui;
        if constexpr (ALIGN_EPI) { if (wr == 1) PG8_BAR; }
    }
    PG8_WAIT_V(0);
    if constexpr (!ALIGN_EPI) { if (wr == 0) PG8_BAR; }
    PG8_BAR;
    if constexpr (Epi::AFTER_DRAIN) { E.fused(acc, cur, wr, wc, fr, fq, lds, wid, lane); S.done(cur); }
#undef PG8_SA
#undef PG8_SB
#undef PG8_STAGE
#undef PG8_LDA
#undef PG8_LDB
#undef PG8_MMA
#undef PG8_WAIT_V
#undef PG8_WAIT_L
#undef PG8_BAR
#undef PG8_SCHED
}
}

namespace pg8 {
struct OneUnit {
    int pm, pn;
    __device__ __forceinline__ bool next(int i, Unit& u) const { if (i) return false; u.pm = pm; u.pn = pn; return true; }
    __device__ __forceinline__ void a_ready(const Unit&) const {}
    __device__ __forceinline__ void done(const Unit&) const {}
};
struct EpiF32 {
    static constexpr bool PERM = false, AFTER_DRAIN = false;
    float* C; int ldc;
    __device__ __forceinline__ void operator()(const f32x4 (&acc)[2][2][4][2], const Unit& u, int wr, int wc, int fr, int fq) const {
        const int row0 = u.pm * BM + wr * 64 + fr, col0 = u.pn * BM + wc * 32 + 4 * fq;
#pragma unroll
        for (int ai = 0; ai < 2; ++ai)
#pragma unroll
            for (int m = 0; m < 4; ++m) { float* rowp = C + (size_t)(row0 + ai * HALF + m * 16) * ldc + col0;
#pragma unroll
                for (int bj = 0; bj < 2; ++bj)
#pragma unroll
                    for (int n = 0; n < 2; ++n) *(f32x4*)(rowp + bj * HALF + n * 16) = acc[ai][bj][m][n]; }
    }
};

struct EpiProj {
    static constexpr bool PERM = false, AFTER_DRAIN = false;
    float* ws; float* out;
    static __device__ __forceinline__ unsigned pk(float lo, float hi) { typedef _Float16 h2v __attribute__((ext_vector_type(2))); h2v p; p.x = (_Float16)lo; p.y = (_Float16)hi; return __builtin_bit_cast(unsigned, p); }
    static __device__ __forceinline__ float silu(float x) { return x / (1.0f + __expf(-x)); }
    static __device__ __forceinline__ float sigm(float x) { return 1.0f / (1.0f + __expf(-x)); }
    __device__ __forceinline__ void operator()(const f32x4 (&acc)[2][2][4][2], const Unit& u, int wr, int wc, int fr, int fq) const {
        typedef unsigned u32x2v __attribute__((ext_vector_type(2)));
        const int pn = u.pn, rowb = u.pm * BM + wr * 64 + fr, colb = wc * 32 + 4 * fq;
        const bool samp = u.pm >= TOK_P / BM;
        if (samp) {
#pragma unroll
            for (int ai = 0; ai < 2; ++ai)
#pragma unroll
                for (int m = 0; m < 4; ++m) { float* rowp = ws + W_PROJ + (size_t)(rowb + ai * HALF + m * 16) * LDP + pn * BM + colb;
#pragma unroll
                    for (int bj = 0; bj < 2; ++bj)
#pragma unroll
                        for (int n = 0; n < 2; ++n) *(f32x4*)(rowp + bj * HALF + n * 16) = acc[ai][bj][m][n]; }
        }
#pragma unroll
        for (int ai = 0; ai < 2; ++ai)
#pragma unroll
            for (int m = 0; m < 4; ++m) {
                const int row = rowb + ai * HALF + m * 16;
                if (pn < 4) {
                    if (!samp) { _Float16* o = (_Float16*)(ws + W_Q16) + (size_t)row * 1024 + pn * BM + colb;
#pragma unroll
                        for (int bj = 0; bj < 2; ++bj)
#pragma unroll
                            for (int n = 0; n < 2; ++n) { const f32x4 v = acc[ai][bj][m][n]; u32x2v w; w.x = pk(v.x, v.y); w.y = pk(v.z, v.w); *(u32x2v*)(o + bj * HALF + n * 16) = w; } }
                } else if (pn < 8) {
                    const int c0 = (pn - 4) * BM + colb;
                    float* of = out + (samp ? O_KVS + (size_t)(row - TOK_P) * 1024 : O_KVP + (size_t)row * 1024) + c0;
#pragma unroll
                    for (int bj = 0; bj < 2; ++bj)
#pragma unroll
                        for (int n = 0; n < 2; ++n) { const f32x4 v = acc[ai][bj][m][n]; *(f32x4*)(of + bj * HALF + n * 16) = v;
                            if (!samp) { u32x2v w; w.x = pk(v.x, v.y); w.y = pk(v.z, v.w); *(u32x2v*)((_Float16*)(ws + W_KVW16) + (size_t)row * 1536 + c0 + bj * HALF + n * 16) = w; } }
                } else if (pn < 10) {
                    const int c0 = (pn - 8) * BM + colb;
                    float* of = nullptr;
                    if (samp) { const int r = row - TOK_P, b = r / DEC_SEQ, t = r % DEC_SEQ; of = out + O_WS + ((size_t)b * KEEP_S + (KEEP_S - DEC_SEQ) + t) * 512 + c0; }
                    else { const int b = row / SEQ, t = row % SEQ; if (t >= SEQ - KEEP_P) of = out + O_WP + ((size_t)b * KEEP_P + (t - (SEQ - KEEP_P))) * 512 + c0; }
#pragma unroll
                    for (int bj = 0; bj < 2; ++bj)
#pragma unroll
                        for (int n = 0; n < 2; ++n) { const f32x4 v = acc[ai][bj][m][n]; if (of) *(f32x4*)(of + bj * HALF + n * 16) = v;
                            if (!samp) { u32x2v w; w.x = pk(v.x, v.y); w.y = pk(v.z, v.w); *(u32x2v*)((_Float16*)(ws + W_KVW16) + (size_t)row * 1536 + 1024 + c0 + bj * HALF + n * 16) = w; } }
                } else if (pn == 10) {
                    if (wc == 0) {
#pragma unroll
                        for (int n = 0; n < 2; ++n) { const int c0 = 16 * n + 4 * fq; if (c0 < 24) { const f32x4 v = acc[ai][0][m][n]; *(f32x4*)(ws + W_GATES + (size_t)row * 32 + c0) = (f32x4){sigm(v.x), sigm(v.y), sigm(v.z), sigm(v.w)}; } } }
                } else if (pn < 15 || pn >= 23) {
                    _Float16* o = (_Float16*)(ws + (pn < 15 ? W_ZN16 : W_ZC16)) + (size_t)row * 1024 + (pn < 15 ? pn - 11 : pn - 23) * BM + colb;
#pragma unroll
                    for (int bj = 0; bj < 2; ++bj)
#pragma unroll
                        for (int n = 0; n < 2; ++n) { const f32x4 v = acc[ai][bj][m][n]; u32x2v w; w.x = pk(silu(v.x), silu(v.y)); w.y = pk(silu(v.z), silu(v.w)); *(u32x2v*)(o + bj * HALF + n * 16) = w; }
                } else {
                    float* o = ws + W_U + (size_t)row * 1024 + (pn - 15) * HALF + colb;
#pragma unroll
                    for (int n = 0; n < 2; ++n) { const f32x4 a = acc[ai][0][m][n], gl = acc[ai][1][m][n];
                        *(f32x4*)(o + n * 16) = (f32x4){a.x * sigm(gl.x), a.y * sigm(gl.y), a.z * sigm(gl.z), a.w * sigm(gl.w)}; }
                }
            }
    }
};
}

namespace fa {
typedef _Float16 h8 __attribute__((ext_vector_type(8)));
typedef _Float16 h4 __attribute__((ext_vector_type(4)));
typedef float f32x16 __attribute__((ext_vector_type(16)));
typedef float f32x4 __attribute__((ext_vector_type(4)));
typedef unsigned u32x4 __attribute__((ext_vector_type(4)));
constexpr int NW = 8, QBLK = 32, KVBLK = 64, QB = NW * QBLK, HD_ = 128;
constexpr int SHM_V = KVBLK * HD_ * 2, SHM_K = KVBLK * HD_ * 2;
constexpr int LDS_NEED = 2 * SHM_V + 2 * SHM_K + NW * 64 * 4;
constexpr int LDQ = 1024, LDK = 1536, LDO = 1024;
constexpr float SCALE = 0.08838834764831845f, THR = 8.f;

#define KSWZ(row, colB) ((row) * 256 + ((colB) ^ (((row) & 7) << 4)))
#define SBAR() __builtin_amdgcn_sched_barrier(0)
__device__ __forceinline__ int v_st(int k, int c) { const int kk = (k & ~0xC) | ((k & 4) << 1) | ((k & 8) >> 1); return ((kk >> 3) * 4 + (c >> 5)) * 512 + ((kk & 7) * 32 + (c & 31)) * 2; }
__device__ __forceinline__ int v_rd_base(int lane) { return ((lane & 3) << 3) | (((lane >> 2) & 3) << 6) | (((lane >> 4) & 1) << 5) | (((lane >> 5) & 1) << 8); }
constexpr int v_rd_off(int d0, int ks, int half) { return d0 * 512 + ks * 4096 + half * 2048; }
__device__ __forceinline__ int crow(int r, int hi) { return (r & 3) + 8 * (r >> 2) + 4 * hi; }
__device__ __forceinline__ unsigned cvtpk(float lo, float hi) { typedef _Float16 h2v __attribute__((ext_vector_type(2))); h2v p; p.x = (_Float16)lo; p.y = (_Float16)hi; return __builtin_bit_cast(unsigned, p); }
__device__ __forceinline__ h8 load8(const _Float16* p) { return *reinterpret_cast<const h8*>(p); }
__device__ __forceinline__ void mask_tile(f32x16& p0, f32x16& p1, int dq, unsigned W) {
    const float NEG = -__builtin_inff();
#pragma unroll
    for (int r = 0; r < 16; ++r) {
        const int c = (r & 3) + 8 * (r >> 2);
        if ((unsigned)(dq - c) >= W) p0[r] = NEG;
        if ((unsigned)(dq - c - 32) >= W) p1[r] = NEG;
    }
}
__device__ __forceinline__ void partialSM(f32x16& p0, f32x16& p1, float& m_reg, float& mn, float& alpha) {
    float pmax = p0[0]; for (int r = 1; r < 16; ++r) pmax = fmaxf(pmax, p0[r]); for (int r = 0; r < 16; ++r) pmax = fmaxf(pmax, p1[r]);
    { auto rr = __builtin_amdgcn_permlane32_swap(__float_as_uint(pmax), __float_as_uint(pmax), false, false);
      pmax = fmaxf(__uint_as_float(rr[0]), __uint_as_float(rr[1])); }
    constexpr float C2 = 1.4426950408889634f * SCALE;
    if (__builtin_expect(__all((pmax - m_reg) * SCALE <= THR), 1)) { mn = m_reg; alpha = 1.f; }
    else { mn = fmaxf(m_reg, pmax); alpha = __builtin_amdgcn_exp2f((m_reg - mn) * C2); m_reg = mn; }
    const float mnL = -mn * C2;
    for (int r = 0; r < 16; ++r) p0[r] = fmaf(p0[r], C2, mnL); for (int r = 0; r < 16; ++r) p1[r] = fmaf(p1[r], C2, mnL);
    for (int r = 0; r < 16; ++r) p0[r] = __builtin_amdgcn_exp2f(p0[r]);
}
__device__ __forceinline__ void finishSM(f32x16& p0, f32x16& p1, float alpha, float& l_reg, h8& pa0, h8& pa1, h8& pa2, h8& pa3) {
    for (int r = 0; r < 16; ++r) p1[r] = __builtin_amdgcn_exp2f(p1[r]);
    float ps = 0; for (int r = 0; r < 16; ++r) ps += p0[r]; for (int r = 0; r < 16; ++r) ps += p1[r];
    { auto rr = __builtin_amdgcn_permlane32_swap(__float_as_uint(ps), __float_as_uint(ps), false, false);
      ps = __uint_as_float(rr[0]) + __uint_as_float(rr[1]); }
    l_reg = l_reg * alpha + ps;
#define PK4(P, B_, OUT) do { unsigned a0 = cvtpk(P[B_+0], P[B_+1]), a1 = cvtpk(P[B_+2], P[B_+3]);                          \
        unsigned b0 = cvtpk(P[B_+4], P[B_+5]), b1 = cvtpk(P[B_+6], P[B_+7]);                                             \
        auto r0 = __builtin_amdgcn_permlane32_swap(a0, b0, false, false); auto r1 = __builtin_amdgcn_permlane32_swap(a1, b1, false, false); \
        u32x4 w = {r0[0], r1[0], r0[1], r1[1]}; OUT = *reinterpret_cast<h8*>(&w); } while (0)
    PK4(p0, 0, pa0); PK4(p0, 8, pa1); PK4(p1, 0, pa2); PK4(p1, 8, pa3);
#undef PK4
}
template <int KB>
__device__ __forceinline__ void qkt(f32x16& p0, f32x16& p1, const char* K_lds, int r32, int hi, const h8* qr) {
    p0 = f32x16{}; p1 = f32x16{};
    const char* kb[4];
#pragma unroll
    for (int dd = 0; dd < 4; ++dd) kb[dd] = K_lds + KB * SHM_K + KSWZ(r32, (dd * 16 + hi * 8) * 2);
#pragma unroll
    for (int d0 = 0; d0 < 8; ++d0) { const char* a = kb[d0 & 3] + (d0 >> 2) * 128;
        h8 b0 = *reinterpret_cast<const h8*>(a);
        h8 b1 = *reinterpret_cast<const h8*>(a + 32 * 256);
        p0 = __builtin_amdgcn_mfma_f32_32x32x16_f16(b0, qr[d0], p0, 0, 0, 0);
        p1 = __builtin_amdgcn_mfma_f32_32x32x16_f16(b1, qr[d0], p1, 0, 0, 0); }
}
template <int VB>
__device__ __forceinline__ void pv_tile(f32x16* o, int vb0, h8 pa0, h8 pa1, h8 pa2, h8 pa3) {
#define TRRD(dst, off) asm volatile("ds_read_b64_tr_b16 %0, %1 offset:%2" : "=&v"(dst) : "v"(vb0), "i"(off) : "memory")
#define PV_D0(d0) do { h4 l0, l1, l2, l3, h0, h1, h2, h3; constexpr int b_ = VB * SHM_V + v_rd_off(d0, 0, 0);   \
        TRRD(l0, b_); TRRD(h0, b_ + 2048); TRRD(l1, b_ + 4096); TRRD(h1, b_ + 6144); TRRD(l2, b_ + 8192); TRRD(h2, b_ + 10240); TRRD(l3, b_ + 12288); TRRD(h3, b_ + 14336); \
        asm volatile("s_waitcnt lgkmcnt(0)" ::: "memory"); SBAR();   \
        o[d0] = __builtin_amdgcn_mfma_f32_32x32x16_f16(pa0, (h8){l0[0], l0[1], l0[2], l0[3], h0[0], h0[1], h0[2], h0[3]}, o[d0], 0, 0, 0);   \
        o[d0] = __builtin_amdgcn_mfma_f32_32x32x16_f16(pa1, (h8){l1[0], l1[1], l1[2], l1[3], h1[0], h1[1], h1[2], h1[3]}, o[d0], 0, 0, 0);   \
        o[d0] = __builtin_amdgcn_mfma_f32_32x32x16_f16(pa2, (h8){l2[0], l2[1], l2[2], l2[3], h2[0], h2[1], h2[2], h2[3]}, o[d0], 0, 0, 0);   \
        o[d0] = __builtin_amdgcn_mfma_f32_32x32x16_f16(pa3, (h8){l3[0], l3[1], l3[2], l3[3], h3[0], h3[1], h3[2], h3[3]}, o[d0], 0, 0, 0); } while (0)
    PV_D0(0); PV_D0(1); PV_D0(2); PV_D0(3);
#undef PV_D0
#undef TRRD
}
constexpr int SELSTRIDE = 4;
struct BlockRef { const _Float16* Q; const _Float16* K; const _Float16* V; float* O; const unsigned* sel; int P0; int W; };
struct Seam { h8 qr[8]; h8 st_v0, st_v1, st_k0, st_k1; };
__device__ __forceinline__ int swa_jlo(int P0, int W) { const int lowk = P0 - W + 1; return lowk > 0 ? lowk / KVBLK : 0; }
#define ROW(p, k0, rr) ((p) + (size_t)((k0) + (rr)) * LDK + sc)
#define VMW() asm volatile("s_waitcnt vmcnt(0)" ::: "memory")
#define VMWN(n) asm volatile("s_waitcnt vmcnt(%0)" :: "i"(n) : "memory")
#define SLOAD_H(Kp, Vp, k0) do { S.st_v0 = load8(ROW(Vp, k0, sr)); S.st_v1 = load8(ROW(Vp, k0, 32 + sr));              \
                         S.st_k0 = load8(ROW(Kp, k0, sr)); S.st_k1 = load8(ROW(Kp, k0, 32 + sr)); } while (0)
#define SWRITE_HK(bf) do { *(h8*)(K_lds + (bf) * SHM_K + kws) = S.st_k0; *(h8*)(K_lds + (bf) * SHM_K + kws + 32 * 256) = S.st_k1; } while (0)
#define SWRITE_HV(bf) do { *(h8*)(V_lds + (bf) * SHM_V + vst0) = S.st_v0; *(h8*)(V_lds + (bf) * SHM_V + vst0 + vst1_off) = S.st_v1; } while (0)
#define SWRITE_H(bf) do { SWRITE_HV(bf); SWRITE_HK(bf); } while (0)
__device__ __forceinline__ void swa_prime(const BlockRef& cur, char* lds, Seam& S) {
    const int tid = threadIdx.x, wid = __builtin_amdgcn_readfirstlane(tid >> 6), lane = tid & 63, r32 = lane & 31, hi = lane >> 5;
    const int sr = tid >> 4, sc = (tid & 15) * 8, kws = KSWZ(sr, sc * 2); char* K_lds = lds + 2 * SHM_V;
    const int kb0 = swa_jlo(cur.P0, cur.W) * KVBLK;
    for (int d0 = 0; d0 < 8; ++d0) S.qr[d0] = load8(cur.Q + (size_t)(wid * QBLK + r32) * LDQ + d0 * 16 + hi * 8);
    SLOAD_H(cur.K, cur.V, kb0); VMW(); SWRITE_HK(0);
    __syncthreads();
}
__device__ __forceinline__ void swa_block(const BlockRef& cur, const BlockRef& nxt, int skv, char* lds, Seam& S) {
    int tid = threadIdx.x; asm volatile("" : "+v"(tid));
    const int wid = __builtin_amdgcn_readfirstlane(tid >> 6), lane = tid & 63, r32 = lane & 31, hi = lane >> 5;
    const int W = cur.W;
    const int j_lo = swa_jlo(cur.P0, W);
    int j_hi = (cur.P0 + QB - 1) / KVBLK + 1; if (j_hi > skv / KVBLK) j_hi = skv / KVBLK;
    const int NT = j_hi - j_lo;
    const int kbn = swa_jlo(nxt.P0, nxt.W) * KVBLK;
    const int qlo = cur.P0 + wid * QBLK, qm = qlo + r32 - 4 * hi;
    char* V_lds = lds; char* K_lds = lds + 2 * SHM_V;
    float* ws = (float*)(lds + 2 * SHM_V + 2 * SHM_K) + wid * 64; float* li_l = ws, * al_l = ws + 32;
    float m_reg = -1e30f, l_reg = 0; f32x16 o[4] = {};
    const int sr = tid >> 4, sc = (tid & 15) * 8, vst0 = v_st(sr, sc), kws = KSWZ(sr, sc * 2); constexpr int vst1_off = 8192;
    const int vb0 = (int)(uintptr_t)V_lds + v_rd_base(lane);
    const _Float16* Kh = cur.K; const _Float16* Vh = cur.V;
    const unsigned selrow = cur.sel ? cur.sel[(size_t)(wid * QBLK + r32) * SELSTRIDE] : 0xffffffffu;
#define RESC(a) do { if (__any((a) < 1.f)) { if (hi == 0) al_l[r32] = (a); asm volatile("s_waitcnt lgkmcnt(0)" ::: "memory");              \
                     for (int d_ = 0; d_ < 4; ++d_) for (int r = 0; r < 16; ++r) o[d_][r] *= al_l[crow(r, hi)]; } } while (0)
#define KBASE(t) ((j_lo + (t)) * KVBLK)
#define MASKT(P0_, P1_, t) do { const int kb_ = KBASE(t); if (kb_ + KVBLK - 1 > qlo || kb_ <= qlo + QBLK - 1 - W) mask_tile(P0_, P1_, qm - kb_, (unsigned)W);   \
        { const bool ok_ = (selrow >> (j_lo + (t))) & 1u; if (!__all(ok_)) { const float NEG_ = -__builtin_inff(); if (!ok_) { for (int r = 0; r < 16; ++r) { P0_[r] = NEG_; P1_[r] = NEG_; } } } } } while (0)
    constexpr int NQL = 8;
#define SEAM_K0() do { VMWN(NQL); SWRITE_HK(0); SBAR(); } while (0)
    f32x16 pA0, pA1, pB0, pB1; float mnA, mnB, alA, alB; h8 pa0, pa1, pa2, pa3;
    SWRITE_HV(0); SBAR();
    if (NT > 1) { SLOAD_H(Kh, Vh, KBASE(1)); }
    SBAR(); qkt<0>(pA0, pA1, K_lds, r32, hi, S.qr);
    MASKT(pA0, pA1, 0); partialSM(pA0, pA1, m_reg, mnA, alA);
    if (NT > 1) { VMW(); SWRITE_H(1); }
    __syncthreads();
#define HALF_STEP(PX0, PX1, mnX, alX, PY0, PY1, alY, t, KB, VB, SB) do {                                                      \
        SBAR(); qkt<KB>(PX0, PX1, K_lds, r32, hi, S.qr);                                             \
        finishSM(PY0, PY1, alY, l_reg, pa0, pa1, pa2, pa3); SBAR();                                                           \
        if ((t) + 1 < NT) { SLOAD_H(Kh, Vh, KBASE((t) + 1)); SBAR(); }                                               \
        pv_tile<VB>(o, vb0, pa0, pa1, pa2, pa3); MASKT(PX0, PX1, (t)); partialSM(PX0, PX1, m_reg, mnX, alX);                                        \
        __syncthreads();                                                                                                      \
        if ((t) + 1 < NT) { VMW(); SWRITE_H(SB); }                                                                          \
        RESC(alX); __syncthreads(); } while (0)
    for (int t = 1; t + 1 < NT; t += 2) {
        HALF_STEP(pB0, pB1, mnB, alB, pA0, pA1, alA, t, 1, 0, 0);
        HALF_STEP(pA0, pA1, mnA, alA, pB0, pB1, alB, t + 1, 0, 1, 1);
    }
    const bool even = (NT & 1) == 0;
    if (even) { SBAR(); qkt<1>(pB0, pB1, K_lds, r32, hi, S.qr); SBAR(); }
    { SLOAD_H(nxt.K, nxt.V, kbn); SBAR();
#pragma unroll
        for (int d0 = 0; d0 < 8; ++d0) S.qr[d0] = load8(nxt.Q + (size_t)(wid * QBLK + r32) * LDQ + d0 * 16 + hi * 8); }
    SBAR();
    finishSM(pA0, pA1, alA, l_reg, pa0, pa1, pa2, pa3); SBAR();
    pv_tile<0>(o, vb0, pa0, pa1, pa2, pa3);
    if (even) { MASKT(pB0, pB1, NT - 1); partialSM(pB0, pB1, m_reg, mnB, alB); __syncthreads(); RESC(alB);
        finishSM(pB0, pB1, alB, l_reg, pa0, pa1, pa2, pa3); SBAR(); pv_tile<1>(o, vb0, pa0, pa1, pa2, pa3); }
    SBAR(); SEAM_K0();
    if (hi == 0) li_l[r32] = l_reg; asm volatile("s_waitcnt lgkmcnt(0)" ::: "memory");
    float rli[16];
#pragma unroll
    for (int r = 0; r < 16; ++r) rli[r] = __builtin_amdgcn_rcpf(li_l[crow(r, hi)]);
    float* Ow = cur.O + (size_t)(wid * QBLK) * LDO;
#pragma unroll
    for (int r = 0; r < 16; ++r) { const int orow = crow(r, hi);
#pragma unroll
        for (int d0 = 0; d0 < 4; ++d0) Ow[(size_t)orow * LDO + d0 * 32 + r32] = o[d0][r] * rli[r]; }
    __syncthreads();
#undef RESC
#undef KBASE
#undef MASKT
#undef SEAM_K0
#undef HALF_STEP
}
#undef ROW
#undef VMW
#undef VMWN
#undef SLOAD_H
#undef SWRITE_HK
#undef SWRITE_HV
#undef SWRITE_H
#undef KSWZ
#undef SBAR
}

namespace cmpb {
typedef _Float16 h8 __attribute__((ext_vector_type(8)));
typedef float f32x4 __attribute__((ext_vector_type(4)));
typedef unsigned u32x4 __attribute__((ext_vector_type(4)));
__device__ __forceinline__ h8 cvt8(f32x4 a, f32x4 b) {
    typedef _Float16 h2v __attribute__((ext_vector_type(2)));
    h2v p0, p1, p2, p3; p0.x = (_Float16)a.x; p0.y = (_Float16)a.y; p1.x = (_Float16)a.z; p1.y = (_Float16)a.w; p2.x = (_Float16)b.x; p2.y = (_Float16)b.y; p3.x = (_Float16)b.z; p3.y = (_Float16)b.w;
    u32x4 w = {__builtin_bit_cast(unsigned, p0), __builtin_bit_cast(unsigned, p1), __builtin_bit_cast(unsigned, p2), __builtin_bit_cast(unsigned, p3)};
    return __builtin_bit_cast(h8, w);
}
__device__ __forceinline__ void compress_unit(const Params& P, char* lds, int seq, int sg) {
    static_assert(NCMP_P == 127 && NCMP_S == 127 && PAGE == 128, "compress_unit is written for 2048 compressed-over positions");
    int tid = threadIdx.x; asm volatile("" : "+v"(tid));
    const int wave = __builtin_amdgcn_readfirstlane(tid >> 6), lane = tid & 63, r16 = lane & 15, kg = lane >> 4, s = sg >> 1;
    const int c = wave * 16 + r16;
    const float* abase; long astride;
    if (seq < BATCH) { abase = P.out + O_KVP + ((long)seq * SEQ + 16 * c) * 1024 + sg * 128 + 8 * kg; astride = 1024; }
    else { const int b = seq - BATCH; const int pg = P.ptab[b * NPAGES + (c >> 3)]; abase = P.cache + ((long)pg * PAGE + 16 * (c & 7)) * 1024 + sg * 128 + 8 * kg; astride = 1024; }
    const _Float16* wsrc = (const _Float16*)(P.ws + W_WC16) + (long)s * 256 * 2048;
    char* buf0 = lds; char* buf1 = lds + 32768;
    f32x4 acc[16];
#pragma unroll
    for (int i = 0; i < 16; ++i) acc[i] = (f32x4){0.f, 0.f, 0.f, 0.f};
    f32x4 a0[4], a1[4], a2[4], a3[4]; u32x4 bs0[4], bs1[4];
    const int nb = tid >> 3, chb = tid & 7;
    const unsigned voffB = (unsigned)((nb * 2048 + chb * 8) * 2);
    const int wrB = nb * 128 + ((chb ^ ((nb >> 1) & 7)) << 4);
    const int rdB = r16 * 128;
#define LOAD_A(dst, tt) do { const float* p_ = abase + (long)((tt) >> 1) * astride + 64 * ((tt) & 1); _Pragma("unroll") for (int ks = 0; ks < 2; ++ks) { dst[2 * ks] = __builtin_nontemporal_load((const f32x4*)(p_ + 32 * ks)); dst[2 * ks + 1] = __builtin_nontemporal_load((const f32x4*)(p_ + 32 * ks + 4)); } } while (0)
#define LOAD_B(bst, tt) do { _Pragma("unroll") for (int i = 0; i < 4; ++i) { const char* ub_ = (const char*)(wsrc + (long)i * 64 * 2048 + (tt) * 64); bst[i] = *(const u32x4*)(ub_ + voffB); } } while (0)
#define WRITE_B(buf, bst) do { _Pragma("unroll") for (int i = 0; i < 4; ++i) *(u32x4*)((buf) + wrB + i * 8192) = bst[i]; } while (0)
#define CSB() __builtin_amdgcn_sched_barrier(0)
#define COMPUTE(a, buf) do { _Pragma("unroll") for (int ks = 0; ks < 2; ++ks) { const h8 af = cvt8(a[2 * ks], a[2 * ks + 1]); const char* rb_ = (buf) + rdB + (((4 * ks + kg) ^ (r16 >> 1)) << 4);   \
        _Pragma("unroll") for (int hf = 0; hf < 2; ++hf) { h8 bf[8];                                                                                              \
            _Pragma("unroll") for (int j = 0; j < 8; ++j) bf[j] = *(const h8*)(rb_ + (8 * hf + j) * 2048);                                                        \
            _Pragma("unroll") for (int j = 0; j < 8; ++j) acc[8 * hf + j] = __builtin_amdgcn_mfma_f32_16x16x32_f16(af, bf[j], acc[8 * hf + j], 0, 0, 0);          \
            CSB(); } } } while (0)
#define STEP(t_, a_, bufc, bufn, bsn) do { __syncthreads();                                                             \
        if ((t_) + 1 < 32) WRITE_B(bufn, bsn);             \
        CSB(); if ((t_) + 3 < 32) LOAD_B(bsn, (t_) + 3);                                                                  \
        CSB(); COMPUTE(a_, bufc); CSB();                                                                                 \
        if ((t_) + 4 < 32) LOAD_A(a_, (t_) + 4);                                                                          \
        CSB(); } while (0)
    LOAD_A(a0, 0); LOAD_A(a1, 1); LOAD_A(a2, 2); LOAD_A(a3, 3); LOAD_B(bs0, 0); WRITE_B(buf0, bs0); LOAD_B(bs1, 1); LOAD_B(bs0, 2);
    for (int t = 0; t < 32; t += 4) {
        STEP(t, a0, buf0, buf1, bs1); STEP(t + 1, a1, buf1, buf0, bs0); STEP(t + 2, a2, buf0, buf1, bs1); STEP(t + 3, a3, buf1, buf0, bs0);
    }
#undef STEP
#undef LOAD_A
#undef LOAD_B
#undef WRITE_B
#undef COMPUTE
#undef CSB
    __syncthreads();
    float* ldsf = (float*)lds; char* R2 = lds + 67584;
#pragma unroll
    for (int nt = 8; nt < 16; ++nt)
#pragma unroll
        for (int i = 0; i < 4; ++i) ldsf[(wave * 16 + 4 * kg + i) * 132 + 16 * (nt - 8) + r16] = acc[nt][i];
    __syncthreads();
#pragma unroll
    for (int nt = 0; nt < 8; ++nt) { const int e = 16 * nt + r16; const float cst = P.ws[W_CCONST + s * 128 + e];
#pragma unroll
        for (int i = 0; i < 4; ++i) { const int cc = wave * 16 + 4 * kg + i; const float hb = cc < 127 ? ldsf[(cc + 1) * 132 + e] : 0.f;
            const float v = acc[nt][i] + hb + cst; const float hh = v / (1.0f + __expf(-v));
            *(_Float16*)(R2 + cc * 256 + (((e >> 3) ^ (cc & 15)) << 4) + (e & 7) * 2) = (_Float16)hh; } }
    __syncthreads();
    f32x4 acc2[8];
#pragma unroll
    for (int i = 0; i < 8; ++i) acc2[i] = (f32x4){0.f, 0.f, 0.f, 0.f};
    const _Float16* w2t = (const _Float16*)(P.ws + W_W2T16) + (long)s * 128 * 128;
#pragma unroll
    for (int ks = 0; ks < 4; ++ks) { const h8 af = *(const h8*)(R2 + c * 256 + (((4 * ks + kg) ^ (c & 15)) << 4));
#pragma unroll
        for (int nt = 0; nt < 8; ++nt) { const h8 bf = *(const h8*)(w2t + (16 * nt + r16) * 128 + 32 * ks + 8 * kg);
            acc2[nt] = __builtin_amdgcn_mfma_f32_16x16x32_f16(af, bf, acc2[nt], 0, 0, 0); } }
    float b2v[8];
#pragma unroll
    for (int nt = 0; nt < 8; ++nt) b2v[nt] = P.b2[s * 128 + 16 * nt + r16];
#pragma unroll
    for (int nt = 0; nt < 8; ++nt)
#pragma unroll
        for (int i = 0; i < 4; ++i) ldsf[(wave * 16 + 4 * kg + i) * 132 + 16 * nt + r16] = acc2[nt][i] + b2v[nt];
    __syncthreads();
#pragma unroll
    for (int it = 0; it < 8; ++it) { const int e = it * 512 + tid, n = e >> 5, c4 = e & 31;
        if (n < 127) *(f32x4*)(P.ws + W_KC + (((long)seq * NCMPX + n) * 4 + sg) * 128 + 4 * c4) = *(const f32x4*)(ldsf + n * 132 + 4 * c4); }
    __syncthreads();
}
}

namespace sam {
typedef float f32x4 __attribute__((ext_vector_type(4)));
constexpr float SC2 = 0.08838834764831845f * 1.4426950408889634f;
struct TileDesc { const float* kb; const float* vb; long stride; int nrows; };
struct Acc { float m, l; f32x4 o[2][4]; };
__device__ __forceinline__ void acc_init(Acc& A) { A.m = -1e30f; A.l = 0.f;
#pragma unroll
    for (int hf = 0; hf < 2; ++hf)
#pragma unroll
        for (int c = 0; c < 4; ++c) A.o[hf][c] = (f32x4){0.f, 0.f, 0.f, 0.f}; }
__device__ __forceinline__ void load_k(f32x4 (&kr)[8], const TileDesc& d, int row0, int lane) {
    const int key = lane & 15, kk = lane >> 4;
    int rk = row0 + key; rk = rk < d.nrows ? rk : d.nrows - 1;
    const float* kp = d.kb + (long)rk * d.stride + 8 * kk;
#pragma unroll
    for (int u = 0; u < 4; ++u) { kr[2 * u] = __builtin_nontemporal_load((const f32x4*)(kp + 32 * u)); kr[2 * u + 1] = __builtin_nontemporal_load((const f32x4*)(kp + 32 * u + 4)); }
}
__device__ __forceinline__ void load_v(f32x4 (&vr)[8], const TileDesc& d, int row0, int lane) {
    const int key = lane & 15, kk = lane >> 4;
#pragma unroll
    for (int i = 0; i < 4; ++i) { int rv = row0 + 4 * kk + i; rv = rv < d.nrows ? rv : d.nrows - 1; const float* vp = d.vb + (long)rv * d.stride + 4 * key;
        vr[2 * i] = __builtin_nontemporal_load((const f32x4*)vp); vr[2 * i + 1] = __builtin_nontemporal_load((const f32x4*)(vp + 64)); }
}
__device__ __forceinline__ f32x4 tile_qk(const f32x4 (&kr)[8], const float* ql, int row0, bool okblk, int lo, int hi, int nrows, int lane) {
    f32x4 s0 = (f32x4){0.f, 0.f, 0.f, 0.f}, s1 = (f32x4){0.f, 0.f, 0.f, 0.f};
#pragma unroll
    for (int u = 0; u < 4; ++u) { const f32x4 qa = *(const f32x4*)(ql + 32 * u), qb = *(const f32x4*)(ql + 32 * u + 4);
#pragma unroll
        for (int c = 0; c < 4; ++c) { s0 = __builtin_amdgcn_mfma_f32_16x16x4f32(kr[2 * u][c], qa[c], s0, 0, 0, 0); s1 = __builtin_amdgcn_mfma_f32_16x16x4f32(kr[2 * u + 1][c], qb[c], s1, 0, 0, 0); } }
    f32x4 s = s0 + s1;
    const int grp = lane >> 4; const float NEG = -__builtin_inff();
#pragma unroll
    for (int i = 0; i < 4; ++i) { const int row = row0 + 4 * grp + i; const bool ok = okblk && row >= lo && row <= hi && row < nrows; s[i] = ok ? s[i] : NEG; }
    return s;
}
__device__ __forceinline__ void tile_pv(const f32x4 s, const f32x4 (&vr)[8], Acc& A, int lane) {
    float mx = fmaxf(fmaxf(s[0], s[1]), fmaxf(s[2], s[3])); mx = fmaxf(mx, __shfl_xor(mx, 16)); mx = fmaxf(mx, __shfl_xor(mx, 32));
    const float mn = fmaxf(A.m, mx), alpha = __builtin_amdgcn_exp2f((A.m - mn) * SC2);
    f32x4 p;
#pragma unroll
    for (int i = 0; i < 4; ++i) p[i] = __builtin_amdgcn_exp2f((s[i] - mn) * SC2);
    float ps = (p[0] + p[1]) + (p[2] + p[3]); ps += __shfl_xor(ps, 16); ps += __shfl_xor(ps, 32);
    A.l = A.l * alpha + ps; A.m = mn;
    if (__any(alpha < 1.f)) {
#pragma unroll
        for (int r = 0; r < 4; ++r) { const float ar = __shfl(alpha, 4 * (lane >> 4) + r);
#pragma unroll
            for (int hf = 0; hf < 2; ++hf)
#pragma unroll
                for (int c = 0; c < 4; ++c) A.o[hf][c][r] *= ar; } }
#pragma unroll
    for (int i = 0; i < 4; ++i)
#pragma unroll
        for (int hf = 0; hf < 2; ++hf)
#pragma unroll
            for (int c = 0; c < 4; ++c) A.o[hf][c] = __builtin_amdgcn_mfma_f32_16x16x4f32(p[i], vr[2 * i + hf][c], A.o[hf][c], 0, 0, 0);
}
constexpr int L_PO = 0, L_PM = 65536, L_PL = 65536 + 512, L_OC = 66560, L_PSUM = 74752, L_SC = 76800, L_SELW = 77440, L_PAGES = 77504, L_SRAW = 77568, L_OW = 77568 + 8 * 64 * 16, L_QL = L_OW + 512 * 16, QL_LD = 132, L_END = L_QL + 16 * QL_LD * 4;
__device__ __forceinline__ TileDesc make_desc(const Params& P, const int* pages, int mode, int blk, int b, int g) {
    TileDesc d; const long tok0 = TOK_P + 4L * b; const int seq = BATCH + b;
    if (mode == 0) { d.kb = P.ws + W_KC + (((long)seq * NCMPX + 64 * blk) * 4 + g) * 128; d.vb = d.kb + 256; d.stride = 512; d.nrows = blk == 0 ? 64 : NCMP_S - 64; }
    else if (mode == 1) {
        if (blk < PAST / 64) { const int pg = pages[blk >> 1]; d.kb = P.cache + ((long)pg * PAGE + (blk & 1) * 64) * 1024 + (4 + g) * 128; d.vb = d.kb + 256; d.stride = 1024; d.nrows = 64; }
        else { d.kb = P.ws + W_PROJ + tok0 * LDP + C_KV + (4 + g) * 128; d.vb = d.kb + 256; d.stride = LDP; d.nrows = DEC_SEQ; } }
    else {
        if (blk < PW / 64) { d.kb = P.swin + ((long)b * PW + 64 * blk) * 512 + g * 128; d.vb = d.kb + 256; d.stride = 512; d.nrows = 64; }
        else { d.kb = P.ws + W_PROJ + tok0 * LDP + C_WIN + g * 128; d.vb = d.kb + 256; d.stride = LDP; d.nrows = DEC_SEQ; } }
    return d;
}
template <bool SRAW>
__device__ __forceinline__ void run_blocks(const Params& P, const int* pages, int mode, unsigned blist, int nb, int b, int g, const float* q, Acc& A, int lane, unsigned selw_lo, unsigned selw_hi, f32x4* sraw_lds) {
    const int t = (lane & 15) >> 2; const int ntile = 4 * nb;
    f32x4 kA[8], kB[8], vA[8], vB[8];
#define DESC(ti) make_desc(P, pages, mode, (int)((blist >> (6 * ((ti) >> 2))) & 63u), b, g)
#define MASKP(ti, okv, lov, hiv) do { const int blk_ = (int)((blist >> (6 * ((ti) >> 2))) & 63u); okv = true; lov = 0; hiv = 63;                                            \
        if (mode == 1) { okv = blk_ < 32 ? ((selw_lo >> blk_) & 1u) : ((selw_hi >> (blk_ - 32)) & 1u); if (blk_ >= PAST / 64) hiv = t; }                                   \
        if (mode == 2) { if (blk_ < PW / 64) lov = t - 64 * blk_; else hiv = t; } } while (0)
#define LOADK(kr, ti) do { const TileDesc d_ = DESC(ti); load_k(kr, d_, 16 * ((ti) & 3), lane); } while (0)
#define LOADV(vr_, ti) do { const TileDesc d_ = DESC(ti); load_v(vr_, d_, 16 * ((ti) & 3), lane); } while (0)
#define STEPT(kcur, vcur, knext, vnext, ti) do { if ((ti) + 1 < ntile) { LOADK(knext, (ti) + 1); LOADV(vnext, (ti) + 1); }                          \
        __builtin_amdgcn_sched_barrier(0);                                                                                                         \
        const TileDesc d_ = DESC(ti); bool ok_; int lo_, hi_; MASKP(ti, ok_, lo_, hi_);                                                            \
        const f32x4 sc_ = tile_qk(kcur, q, 16 * ((ti) & 3), ok_, lo_, hi_, d_.nrows, lane); if (SRAW) sraw_lds[(ti) * 64 + lane] = sc_;            \
        tile_pv(sc_, vcur, A, lane);                                                                                                               \
        __builtin_amdgcn_sched_barrier(0); } while (0)
    if (ntile > 0) { LOADK(kA, 0); LOADV(vA, 0); }
    for (int ti = 0; ti < ntile; ti += 2) {
        STEPT(kA, vA, kB, vB, ti);
        if (ti + 1 < ntile) STEPT(kB, vB, kA, vA, ti + 1);
    }
#undef LOADK
#undef LOADV
#undef STEPT
#undef DESC
#undef MASKP
}
__device__ __forceinline__ void write_partial(char* lds, const Acc& A, int wave, int lane) {
    const int j = lane & 15, rg = lane >> 4;
#pragma unroll
    for (int hf = 0; hf < 2; ++hf)
#pragma unroll
        for (int r = 0; r < 4; ++r) *(f32x4*)(lds + L_PO + wave * 8192 + ((4 * rg + r) * 128 + 64 * hf + 4 * j) * 4) = (f32x4){A.o[hf][0][r], A.o[hf][1][r], A.o[hf][2][r], A.o[hf][3][r]};
    if (lane < 16) { ((float*)(lds + L_PM))[wave * 16 + lane] = A.m; ((float*)(lds + L_PL))[wave * 16 + lane] = A.l; }
}
__device__ __forceinline__ f32x4 combine_partials(const char* lds, int tid) {
    const int qrow = tid >> 5, d4 = tid & 31; const float* pm = (const float*)(lds + L_PM); const float* pl = (const float*)(lds + L_PL);
    float M = pm[qrow];
#pragma unroll
    for (int w = 1; w < 8; ++w) M = fmaxf(M, pm[w * 16 + qrow]);
    float L = 0.f; f32x4 o = (f32x4){0.f, 0.f, 0.f, 0.f};
#pragma unroll
    for (int w = 0; w < 8; ++w) { const float e = __builtin_amdgcn_exp2f((pm[w * 16 + qrow] - M) * SC2); L += pl[w * 16 + qrow] * e; o += *(const f32x4*)(lds + L_PO + w * 8192 + (qrow * 128 + 4 * d4) * 4) * e; }
    return o * (1.0f / L);
}
__device__ __forceinline__ void sample_unit(const Params& P, char* lds, int b, int g) {
    static_assert(PAST == 2048 && DEC_SEQ == 4 && PW == 512 && NCMP_S == 127 && NSEL_S == 33, "sample_unit is written for a 2048-token paged past and 4 new tokens");
    int tid, wave, lane, qrow, kk, t, r;
#define REFRESH_IDS() do { tid = threadIdx.x; asm volatile("" : "+v"(tid)); wave = __builtin_amdgcn_readfirstlane(tid >> 6); lane = tid & 63; qrow = lane & 15; kk = lane >> 4; t = qrow >> 2; r = qrow & 3; } while (0)
    REFRESH_IDS();
    const long tok0 = TOK_P + 4L * b;
    int* pages = (int*)(lds + L_PAGES); float* psum = (float*)(lds + L_PSUM); float* scv = (float*)(lds + L_SC); unsigned* selw = (unsigned*)(lds + L_SELW);
    if (tid < NPAGES) pages[tid] = P.ptab[b * NPAGES + tid];
    if (tid < 8) selw[tid] = 0u;
    { const int qr_ = tid >> 5, c4_ = tid & 31; float* qlw = (float*)(lds + L_QL);
      *(f32x4*)(qlw + qr_ * QL_LD + 4 * c4_) = *(const f32x4*)(P.ws + W_PROJ + (tok0 + (qr_ >> 2)) * LDP + C_Q + (4 * g + (qr_ & 3)) * 128 + 4 * c4_); }
    const float* q = (const float*)(lds + L_QL) + qrow * QL_LD + 8 * kk;
    __syncthreads();
    f32x4 o_slc, o_win;
    {
        Acc A; acc_init(A);
        if (wave == 0) {
            f32x4* sraw = (f32x4*)(lds + L_SRAW);
            run_blocks<true>(P, pages, 0, 0u | (1u << 6), 2, b, g, q, A, lane, 0u, 0u, sraw);
            REFRESH_IDS();
            const float inv = 1.0f / A.l;
#pragma unroll
            for (int ti = 0; ti < 8; ++ti) { const f32x4 sv = sraw[ti * 64 + lane];
#pragma unroll
                for (int i = 0; i < 4; ++i) { float p = __builtin_amdgcn_exp2f((sv[i] - A.m) * SC2) * inv; p += __shfl_xor(p, 1); p += __shfl_xor(p, 2);
                    if (r == 0) psum[t * 128 + 16 * ti + 4 * kk + i] = p; } }
            const int j = lane & 15, rg = lane >> 4;
#pragma unroll
            for (int rr = 0; rr < 4; ++rr) { const float il = __shfl(inv, 4 * rg + rr);
#pragma unroll
                for (int hf = 0; hf < 2; ++hf) *(f32x4*)(lds + L_OC + ((4 * rg + rr) * 128 + 64 * hf + 4 * j) * 4) = (f32x4){A.o[hf][0][rr], A.o[hf][1][rr], A.o[hf][2][rr], A.o[hf][3][rr]} * il; }
            acc_init(A);
        } else {
            const unsigned blist = (unsigned)(wave - 1) | ((unsigned)(6 + wave) << 6); const int nb = wave <= 2 ? 2 : 1;
            run_blocks<false>(P, pages, 2, blist, nb, b, g, q, A, lane, 0u, 0u, nullptr);
        }
        REFRESH_IDS();
        write_partial(lds, A, wave, lane);
    }
    __syncthreads();
    o_win = combine_partials(lds, tid);
    *(f32x4*)(lds + L_OW + tid * 16) = o_win;
    const int st = tid / NSEL_S, sj = tid % NSEL_S; float myscore = 0.f; bool allowed = false;
    if (tid < 4 * NSEL_S) {
        const int qpos = PAST + st, cur = qpos / 64;
        int n0 = 4 * sj - 1; if (n0 < 0) n0 = 0; int n1 = 4 * sj + 3; if (n1 > NCMP_S - 1) n1 = NCMP_S - 1;
        float imp = 0.f; for (int n = n0; n <= n1; ++n) imp += psum[st * 128 + n];
        allowed = sj * 64 <= qpos; const bool forced = (sj == 0) || (sj == cur) || (sj == cur - 1);
        myscore = allowed ? imp + (forced ? 1e6f : 0.0f) : -1e30f;
        scv[st * 40 + sj] = myscore;
    }
    __syncthreads();
    if (tid < 4 * NSEL_S) {
        int rank = 0;
        for (int j2 = 0; j2 < NSEL_S; ++j2) { const float o2 = scv[st * 40 + j2]; rank += (o2 > myscore || (o2 == myscore && j2 < sj)) ? 1 : 0; }
        if (allowed && rank < 16) atomicOr(&selw[st * 2 + (sj >> 5)], 1u << (sj & 31));
    }
    __syncthreads();
    {
        const unsigned ulo = selw[0] | selw[2] | selw[4] | selw[6], uhi = selw[1] | selw[3] | selw[5] | selw[7];
        unsigned blist = 0u; int nb = 0, cnt = 0;
        for (int j2 = 0; j2 < NSEL_S; ++j2) { const bool on = j2 < 32 ? ((ulo >> j2) & 1u) : ((uhi >> (j2 - 32)) & 1u); if (on) { if ((cnt & 7) == wave) { blist |= (unsigned)j2 << (6 * nb); ++nb; } ++cnt; } }
        Acc A; acc_init(A);
        run_blocks<false>(P, pages, 1, blist, nb, b, g, q, A, lane, selw[2 * t], selw[2 * t + 1], nullptr);
        REFRESH_IDS();
        write_partial(lds, A, wave, lane);
        __syncthreads();
        o_slc = combine_partials(lds, tid);
    }
    {
        REFRESH_IDS(); o_win = *(const f32x4*)(lds + L_OW + tid * 16);
        const int orow = tid >> 5, d4 = tid & 31, ot = orow >> 2, h = 4 * g + (orow & 3); const long tok = tok0 + ot; const float* pr = P.ws + W_PROJ + tok * LDP;
        const float g0 = sigmoid_f(pr[C_GATE + h]), g1 = sigmoid_f(pr[C_GATE + 8 + h]), g2 = sigmoid_f(pr[C_GATE + 16 + h]);
        const f32x4 oc = *(const f32x4*)(lds + L_OC + (orow * 128 + 4 * d4) * 4), z = *(const f32x4*)(pr + C_ZN + h * 128 + 4 * d4);
        const f32x4 o = oc * g0 + o_slc * g1 + o_win * g2; f32x4 m;
        m.x = o.x * silu_f(z.x); m.y = o.y * silu_f(z.y); m.z = o.z * silu_f(z.z); m.w = o.w * silu_f(z.w);
        *(f32x4*)(P.ws + W_MIX + tok * D + h * 128 + 4 * d4) = m;
        typedef _Float16 h2v __attribute__((ext_vector_type(2))); typedef unsigned u32x2v __attribute__((ext_vector_type(2)));
        h2v p0, p1; p0.x = (_Float16)m.x; p0.y = (_Float16)m.y; p1.x = (_Float16)m.z; p1.y = (_Float16)m.w;
        u32x2v w2; w2.x = __builtin_bit_cast(unsigned, p0); w2.y = __builtin_bit_cast(unsigned, p1);
        *(u32x2v*)((_Float16*)(P.ws + W_MIX16) + tok * D + h * 128 + 4 * d4) = w2;
    }
    __syncthreads();
#undef REFRESH_IDS
}
}

namespace cmpa {
using fa::h8; using fa::f32x16; using fa::SHM_K; using fa::SHM_V;
constexpr int L_V = 0, L_K = 2 * SHM_V, L_PS = 65536, PS_LD = 129, L_SC = L_PS + 64 * PS_LD * 4, SC_LD = 33, L_END = L_SC + 64 * SC_LD * 4;
__device__ __forceinline__ h8 cvt8f(const float* p, bool ok) {
    typedef float f4 __attribute__((ext_vector_type(4))); typedef unsigned u4 __attribute__((ext_vector_type(4)));
    f4 a = (f4){0.f, 0.f, 0.f, 0.f}, b = a; if (ok) { a = *(const f4*)p; b = *(const f4*)(p + 4); }
    u4 w = {fa::cvtpk(a.x, a.y), fa::cvtpk(a.z, a.w), fa::cvtpk(b.x, b.y), fa::cvtpk(b.z, b.w)}; return __builtin_bit_cast(h8, w);
}
__device__ __forceinline__ void pack_frags(const f32x16& p0, const f32x16& p1, h8& pa0, h8& pa1, h8& pa2, h8& pa3) {
    typedef unsigned u4 __attribute__((ext_vector_type(4)));
#define PK4(P, B_, OUT) do { unsigned a0 = fa::cvtpk(P[B_+0], P[B_+1]), a1 = fa::cvtpk(P[B_+2], P[B_+3]);                          \
        unsigned b0 = fa::cvtpk(P[B_+4], P[B_+5]), b1 = fa::cvtpk(P[B_+6], P[B_+7]);                                             \
        auto r0 = __builtin_amdgcn_permlane32_swap(a0, b0, false, false); auto r1 = __builtin_amdgcn_permlane32_swap(a1, b1, false, false); \
        u4 w = {r0[0], r1[0], r0[1], r1[1]}; OUT = __builtin_bit_cast(h8, w); } while (0)
    PK4(p0, 0, pa0); PK4(p0, 8, pa1); PK4(p1, 0, pa2); PK4(p1, 8, pa3);
#undef PK4
}
__device__ __forceinline__ void unit(const Params& P, char* lds, int b, int g, int tt) {
    static_assert(NCMP_P == 127 && NSEL_P == 32, "cmpa::unit is written for 2048 prompt tokens");
    int tid = threadIdx.x; asm volatile("" : "+v"(tid));
    const int wid = __builtin_amdgcn_readfirstlane(tid >> 6), lane = tid & 63, r32 = lane & 31, hi = lane >> 5;
    const int hr = wid & 3, tsub = wid >> 2, h = 4 * g + hr, tl = 32 * tsub + r32, t_abs = 64 * tt + tl; const long tokw0 = (long)b * SEQ + 64 * tt + 32 * tsub;
    char* V_lds = lds + L_V; char* K_lds = lds + L_K; float* psum = (float*)(lds + L_PS); float* scv = (float*)(lds + L_SC);
    h8 qr[8];
#pragma unroll
    for (int d0 = 0; d0 < 8; ++d0) qr[d0] = fa::load8((const _Float16*)(P.ws + W_Q16) + (tokw0 + r32) * 1024 + h * 128 + d0 * 16 + hi * 8);
    { const int sr = tid >> 4, sc = (tid & 15) * 8;
#pragma unroll
      for (int tile = 0; tile < 2; ++tile)
#pragma unroll
          for (int hf = 0; hf < 2; ++hf) { const int n = 64 * tile + 32 * hf + sr; const bool ok = n < NCMP_P;
              const float* src = P.ws + W_KC + (((long)b * NCMPX + (ok ? n : 0)) * 4 + g) * 128 + sc;
              *(h8*)(K_lds + tile * SHM_K + ((sr) * 256 + ((sc * 2) ^ (((sr) & 7) << 4))) + hf * 32 * 256) = cvt8f(src, ok);
              *(h8*)(V_lds + tile * SHM_V + fa::v_st(32 * hf + sr, sc)) = cvt8f(src + 256, ok); } }
    __syncthreads();
    f32x16 pA0, pA1, pB0, pB1;
    fa::qkt<0>(pA0, pA1, K_lds, r32, hi, qr); fa::qkt<1>(pB0, pB1, K_lds, r32, hi, qr);
    const int nmax = t_abs >= 31 ? (t_abs - 31) >> 4 : -1; const float NEG = -__builtin_inff();
    float mx = NEG;
#pragma unroll
    for (int r = 0; r < 16; ++r) { const int c = (r & 3) + 8 * (r >> 2) + 4 * hi;
        pA0[r] = (c <= nmax) ? pA0[r] : NEG; pA1[r] = (c + 32 <= nmax) ? pA1[r] : NEG; pB0[r] = (c + 64 <= nmax) ? pB0[r] : NEG; pB1[r] = (c + 96 <= nmax) ? pB1[r] : NEG;
        mx = fmaxf(fmaxf(mx, pA0[r]), fmaxf(pA1[r], fmaxf(pB0[r], pB1[r]))); }
    { auto rr = __builtin_amdgcn_permlane32_swap(__float_as_uint(mx), __float_as_uint(mx), false, false); mx = fmaxf(__uint_as_float(rr[0]), __uint_as_float(rr[1])); }
    if (!(mx > -1e30f)) mx = 0.f;
    constexpr float C2 = 1.4426950408889634f * fa::SCALE; const float mnL = -mx * C2; float ps = 0.f;
#pragma unroll
    for (int r = 0; r < 16; ++r) { pA0[r] = __builtin_amdgcn_exp2f(fmaf(pA0[r], C2, mnL)); pA1[r] = __builtin_amdgcn_exp2f(fmaf(pA1[r], C2, mnL));
        pB0[r] = __builtin_amdgcn_exp2f(fmaf(pB0[r], C2, mnL)); pB1[r] = __builtin_amdgcn_exp2f(fmaf(pB1[r], C2, mnL)); ps += (pA0[r] + pA1[r]) + (pB0[r] + pB1[r]); }
    { auto rr = __builtin_amdgcn_permlane32_swap(__float_as_uint(ps), __float_as_uint(ps), false, false); ps = __uint_as_float(rr[0]) + __uint_as_float(rr[1]); }
    const float inv = ps > 0.f ? 1.0f / ps : 0.f;
#pragma unroll
    for (int r = 0; r < 16; ++r) { pA0[r] *= inv; pA1[r] *= inv; pB0[r] *= inv; pB1[r] *= inv; }
#pragma unroll
    for (int rnd = 0; rnd < 4; ++rnd) {
        if (hr == rnd) {
#pragma unroll
            for (int r = 0; r < 16; ++r) { const int c = (r & 3) + 8 * (r >> 2) + 4 * hi; float* q_ = psum + tl * PS_LD + c;
                if (rnd == 0) { q_[0] = pA0[r]; q_[32] = pA1[r]; q_[64] = pB0[r]; q_[96] = pB1[r]; }
                else { q_[0] += pA0[r]; q_[32] += pA1[r]; q_[64] += pB0[r]; q_[96] += pB1[r]; } } }
        __syncthreads();
    }
    {
        f32x16 o[4] = {}; h8 pa0, pa1, pa2, pa3; const int vb0 = (int)(uintptr_t)V_lds + fa::v_rd_base(lane);
        pack_frags(pA0, pA1, pa0, pa1, pa2, pa3); fa::pv_tile<0>(o, vb0, pa0, pa1, pa2, pa3);
        pack_frags(pB0, pB1, pa0, pa1, pa2, pa3); fa::pv_tile<1>(o, vb0, pa0, pa1, pa2, pa3);
        float* Ow = P.ws + W_OCMP + tokw0 * 1024 + h * 128;
#pragma unroll
        for (int r = 0; r < 16; ++r) { const int orow = fa::crow(r, hi);
#pragma unroll
            for (int d0 = 0; d0 < 4; ++d0) Ow[(size_t)orow * 1024 + d0 * 32 + r32] = o[d0][r]; }
    }
#pragma unroll
    for (int it = 0; it < 4; ++it) { const int idx = it * 512 + tid, t = idx >> 5, j = idx & 31, qpos = 64 * tt + t, cur = qpos >> 6;
        int n0 = 4 * j - 1; if (n0 < 0) n0 = 0; int n1 = 4 * j + 3; if (n1 > NCMP_P - 1) n1 = NCMP_P - 1;
        float imp = 0.f; for (int n = n0; n <= n1; ++n) imp += psum[t * PS_LD + n];
        const bool allowed = j * 64 <= qpos, forced = (j == 0) || (j == cur) || (j == cur - 1);
        scv[t * SC_LD + j] = allowed ? imp + (forced ? 1e6f : 0.0f) : -1e30f; }
    __syncthreads();
#pragma unroll
    for (int it = 0; it < 4; ++it) { const int idx = it * 512 + tid, t = idx >> 5, j = idx & 31, qpos = 64 * tt + t;
        const float my = scv[t * SC_LD + j]; int rank = 0;
        for (int j2 = 0; j2 < 32; ++j2) { const float o2 = scv[t * SC_LD + j2]; rank += (o2 > my || (o2 == my && j2 < j)) ? 1 : 0; }
        const bool sel = (j * 64 <= qpos) && rank < 16;
        const unsigned long long bal = __ballot(sel);
        if ((lane & 31) == 0) { unsigned* o = (unsigned*)(P.ws + W_SEL) + (((long)b * SEQ + qpos) * 2 + g) * 2; o[0] = (unsigned)(lane == 0 ? bal : (bal >> 32)); o[1] = 0u; } }
    __syncthreads();
}
}


namespace cvb {
template <int TC, bool HEAD>
__device__ __forceinline__ void conv_unit(const Params& P, char* lds, int seq, int t0r) {
    const int t0 = t0r;
    int tid = threadIdx.x; asm volatile("" : "+v"(tid));
    const int wave = __builtin_amdgcn_readfirstlane(tid >> 6), lane = tid & 63;
    constexpr int NTH_ = 512, NR = TC + CONVW - 1, NIT = (NR * 256 + NTH_ - 1) / NTH_;
    static_assert(NR * 2048 + TC * 2048 + TC * 64 <= 131072, "LDS map");
    typedef float f4 __attribute__((ext_vector_type(4))); typedef float f2 __attribute__((ext_vector_type(2))); typedef unsigned u2 __attribute__((ext_vector_type(2))); typedef _Float16 h2v __attribute__((ext_vector_type(2)));
    _Float16* ul = (_Float16*)lds; _Float16* cvl = (_Float16*)(lds + NR * 2048); float* red = (float*)(lds + NR * 2048 + TC * 2048);
    const long tokb = tok_of(seq, 0);
#pragma unroll
    for (int it0 = 0; it0 < NIT; it0 += 16) {
        f4 v[16];
#pragma unroll
        for (int q = 0; q < 16; ++q) { const int it = it0 + q, e = it * NTH_ + tid, r = e >> 8, c4 = e & 255; v[q] = (f4){0.f, 0.f, 0.f, 0.f};
            if (it < NIT && r < NR) { const float* src = nullptr;
                const int idx = t0 + r;
                if (HEAD && idx < 30) { if (seq >= BATCH) src = P.sconv + ((long)(seq - BATCH) * 30 + idx) * 1024; }
                else src = P.ws + W_U + (tokb + idx - 30) * 1024;
                if (src) v[q] = *(const f4*)(src + 4 * c4); } }
#pragma unroll
        for (int q = 0; q < 16; ++q) { const int it = it0 + q, e = it * NTH_ + tid, r = e >> 8, c4 = e & 255;
            if (it < NIT && r < NR) { h2v p0, p1; p0.x = (_Float16)v[q].x; p0.y = (_Float16)v[q].y; p1.x = (_Float16)v[q].z; p1.y = (_Float16)v[q].w;
                u2 w; w.x = __builtin_bit_cast(unsigned, p0); w.y = __builtin_bit_cast(unsigned, p1); *(u2*)(ul + r * 1024 + 4 * c4) = w; } }
    }
    float w0[CONVW], w1[CONVW];
#pragma unroll
    for (int k = 0; k < CONVW; ++k) { const f2 ww = *(const f2*)(P.dw + k * 1024 + 2 * tid); w0[k] = ww.x; w1[k] = ww.y; }
    const f2 bb = *(const f2*)(P.db + 2 * tid);
    __syncthreads();
#pragma unroll 1
    for (int tt = 0; tt < TC; ++tt) {
        float a0 = bb.x, a1 = bb.y;
#pragma unroll
        for (int k = 0; k < CONVW; ++k) { const h2v uu = *(const h2v*)(ul + (tt + k) * 1024 + 2 * tid); a0 += w0[k] * (float)uu.x; a1 += w1[k] * (float)uu.y; }
        h2v cc; cc.x = (_Float16)a0; cc.y = (_Float16)a1; *(h2v*)(cvl + tt * 1024 + 2 * tid) = cc;
        const float c0 = (float)cc.x, c1 = (float)cc.y; float s1 = c0 + c1, s2 = c0 * c0 + c1 * c1;
#pragma unroll
        for (int o = 1; o < 64; o <<= 1) { s1 += __shfl_xor(s1, o); s2 += __shfl_xor(s2, o); }
        if (lane == 0) { red[(tt * 8 + wave) * 2] = s1; red[(tt * 8 + wave) * 2 + 1] = s2; }
    }
    __syncthreads();
    { const _Float16* zsrc = (const _Float16*)(P.ws + W_ZC16) + (tokb + t0) * 1024;
      typedef unsigned u4 __attribute__((ext_vector_type(4)));
#pragma unroll
      for (int it = 0; it < (TC * 128 + NTH_ - 1) / NTH_; ++it) { const int e = it * NTH_ + tid; if (e < TC * 128) *(u4*)(ul + e * 8) = *(const u4*)(zsrc + e * 8); } }
    const f2 gg = *(const f2*)(P.lng + 2 * tid), be = *(const f2*)(P.lnb + 2 * tid);
    __syncthreads();
#pragma unroll 1
    for (int tt = 0; tt < TC; ++tt) {
        float s1 = 0.f, s2 = 0.f;
#pragma unroll
        for (int w = 0; w < 8; ++w) { s1 += red[(tt * 8 + w) * 2]; s2 += red[(tt * 8 + w) * 2 + 1]; }
        const float mu = s1 * (1.0f / 1024), var = s2 * (1.0f / 1024) - mu * mu, rstd = rsqrtf(fmaxf(var, 0.f) + 1e-6f);
        const h2v cc = *(const h2v*)(cvl + tt * 1024 + 2 * tid), zz = *(const h2v*)(ul + tt * 1024 + 2 * tid);
        const float l0 = ((float)cc.x - mu) * rstd * gg.x + be.x, l1 = ((float)cc.y - mu) * rstd * gg.y + be.y;
        h2v mm; mm.x = (_Float16)(l0 / (1.0f + __expf(-l0)) * (float)zz.x); mm.y = (_Float16)(l1 / (1.0f + __expf(-l1)) * (float)zz.y);
        *(h2v*)((_Float16*)(P.ws + W_MIX16) + (tokb + t0 + tt) * D + 1024 + 2 * tid) = mm;
    }
    __syncthreads();
}
}

#define XB_TMO      128
#define XB_XCNT(j)  (256  + 64 * (j))
#define XB_XSUB(j)  (1280 + 64 * (j))
#define XB_XGEN(j)  (2304 + 64 * (j))
#define XB_TOP      3328
#define XB_TOPGEN   3392
#define XCD_BAR_WORDS 3456
#define XB_SPIN_CAP (1u << 22)
__device__ __forceinline__ unsigned xb_ld(unsigned* p)              { return __hip_atomic_load(p, __ATOMIC_RELAXED, __HIP_MEMORY_SCOPE_AGENT); }
__device__ __forceinline__ unsigned xb_add(unsigned* p, unsigned v) { return __hip_atomic_fetch_add(p, v, __ATOMIC_RELAXED, __HIP_MEMORY_SCOPE_AGENT); }
__device__ __forceinline__ unsigned xb_xcc_id() { return (unsigned)__builtin_amdgcn_s_getreg((3 << 11) | 20) & 0xFu; }
#define XB_SPIN(cond, bar) do { unsigned _sp = 0; while (cond) { __builtin_amdgcn_s_sleep(1); \
    if ((++_sp & 255u) == 0u) { if (xb_ld(&(bar)[XB_TMO])) break; if (_sp > XB_SPIN_CAP) { atomicAdd(&(bar)[XB_TMO], 1u); break; } } } } while (0)
struct XcdBarrier { unsigned* bar; unsigned x; volatile LAS unsigned* st; };
__device__ __forceinline__ XcdBarrier xcd_barrier_post(unsigned* bar, volatile LAS unsigned* st) {
    XcdBarrier b; b.bar = bar; b.x = xb_xcc_id(); b.st = st;
    if (threadIdx.x == 0) (void)xb_add(&bar[XB_XCNT(b.x)], 1u);
    return b;
}
__device__ __forceinline__ void xcd_barrier_complete(unsigned* bar, unsigned x, unsigned& nloc, unsigned& nx) {
    const unsigned G = gridDim.x * gridDim.y * gridDim.z;
    unsigned sum, cnt, mine, sp = 0u;
    for (;;) {
        sum = 0u; cnt = 0u; mine = 0u;
#pragma unroll
        for (unsigned j = 0; j < 16; ++j) { const unsigned c = xb_ld(&bar[XB_XCNT(j)]); sum += c; cnt += (c > 0u) ? 1u : 0u; mine = (j == x) ? c : mine; }
        if (sum == G) break;
        __builtin_amdgcn_s_sleep(1);
        if ((++sp & 255u) == 0u) { if (xb_ld(&bar[XB_TMO])) break; if (sp > XB_SPIN_CAP) { atomicAdd(&bar[XB_TMO], 1u); break; } }
    }
    nloc = mine > 0u ? mine : 1u; nx = cnt > 0u ? cnt : 1u;
}
__device__ __forceinline__ void xcd_barrier(const XcdBarrier& b) {
    asm volatile("s_waitcnt vmcnt(0)" ::: "memory");
    __syncthreads();
    if (threadIdx.x == 0) {
        unsigned* bar = b.bar;
        __builtin_amdgcn_s_waitcnt(0);
        unsigned nloc = b.st[0], nx = b.st[1];
        if (nloc == 0u) { xcd_barrier_complete(bar, b.x, nloc, nx); b.st[0] = nloc; b.st[1] = nx; }
        const unsigned old = xb_add(&bar[XB_XSUB(b.x)], 1u);
        const unsigned gen = old / nloc;
        if (old + 1u == (gen + 1u) * nloc) {
            __builtin_amdgcn_fence(__ATOMIC_RELEASE, "agent");
            asm volatile("s_waitcnt vmcnt(0)" ::: "memory");
            const unsigned og = xb_add(&bar[XB_TOP], 1u);
            const unsigned tg = og / nx;
            if (og + 1u == (tg + 1u) * nx) xb_add(&bar[XB_TOPGEN], 1u);
            else XB_SPIN(xb_ld(&bar[XB_TOPGEN]) == tg, bar);
            __builtin_amdgcn_fence(__ATOMIC_ACQUIRE, "agent");
            xb_add(&bar[XB_XGEN(b.x)], 1u);
            asm volatile("s_waitcnt vmcnt(0)" ::: "memory");
        } else {
            XB_SPIN(xb_ld(&bar[XB_XGEN(b.x)]) == gen, bar);
            __builtin_amdgcn_fence(__ATOMIC_ACQUIRE, "agent");
            asm volatile("s_waitcnt vmcnt(0)" ::: "memory");
        }
    }
    __syncthreads();
}

constexpr int NTHREADS = 512, NWAVES = 8;
constexpr int LDS_BYTES = 147456;
constexpr int LDS_MISC = 131072;
constexpr int CW_BAR = 4096;
constexpr int CW_QATT = 8192;

namespace modb {
typedef _Float16 h8 __attribute__((ext_vector_type(8)));
typedef float f32x4 __attribute__((ext_vector_type(4)));
typedef unsigned u32x4 __attribute__((ext_vector_type(4)));
constexpr int MT = (NSEQ + 15) / 16, N_ITEMS = 2 * (6144 / 128);
__device__ __forceinline__ unsigned pk(float lo, float hi) { typedef _Float16 h2v __attribute__((ext_vector_type(2))); h2v p; p.x = (_Float16)lo; p.y = (_Float16)hi; return __builtin_bit_cast(unsigned, p); }
__device__ __forceinline__ void mod_item(const Params& P, char* lds, int item) {
    int tid = threadIdx.x; asm volatile("" : "+v"(tid));
    const int wave = __builtin_amdgcn_readfirstlane(tid >> 6), lane = tid & 63, r16 = lane & 15, kg = lane >> 4;
    const int kh = item & 1, n0 = (item >> 1) * 128 + wave * 16;
    f32x4 acc[MT];
#pragma unroll
    for (int i = 0; i < MT; ++i) acc[i] = (f32x4){0.f, 0.f, 0.f, 0.f};
    for (int ch = kh * (D / 512); ch < (kh + 1) * (D / 512); ++ch) {
        const float* wp = P.w_ada + (long)(256 * ch + 8 * kg) * 6144 + n0 + r16;
        float wv[8][8];
#pragma unroll
        for (int ks = 0; ks < 8; ++ks)
#pragma unroll
            for (int j = 0; j < 8; ++j) wv[ks][j] = wp[(long)(32 * ks + j) * 6144];
        __builtin_amdgcn_sched_barrier(0);
        static_assert(MT * 16 * 32 == 9 * NTHREADS, "slab items per thread");
        f32x4 ca[9], cb[9];
#pragma unroll
        for (int it = 0; it < 9; ++it) { const int idx = tid + it * NTHREADS, m = idx >> 5, ck = idx & 31; ca[it] = (f32x4){0.f, 0.f, 0.f, 0.f}; cb[it] = ca[it];
            if (m < NSEQ) { const float* c = (m < BATCH ? P.c_p + (long)m * D : P.c_s + (long)(m - BATCH) * D) + 256 * ch + 8 * ck; ca[it] = *(const f32x4*)c; cb[it] = *(const f32x4*)(c + 4); } }
#pragma unroll
        for (int it = 0; it < 9; ++it) { const int idx = tid + it * NTHREADS, m = idx >> 5, ck = idx & 31; const f32x4 a = ca[it], b = cb[it];
#define SL_(x) ((x) / (1.0f + __expf(-(x))))
            u32x4 w = {pk(SL_(a.x), SL_(a.y)), pk(SL_(a.z), SL_(a.w)), pk(SL_(b.x), SL_(b.y)), pk(SL_(b.z), SL_(b.w))};
#undef SL_
            *(u32x4*)(lds + m * 512 + ((ck ^ (m & 15)) << 4)) = w; }
        __syncthreads();
#pragma unroll
        for (int ks = 0; ks < 8; ++ks) {
            u32x4 bw = {pk(wv[ks][0], wv[ks][1]), pk(wv[ks][2], wv[ks][3]), pk(wv[ks][4], wv[ks][5]), pk(wv[ks][6], wv[ks][7])}; const h8 bf = __builtin_bit_cast(h8, bw);
#pragma unroll
            for (int mt = 0; mt < MT; ++mt) { const h8 af = *(const h8*)(lds + (16 * mt + r16) * 512 + (((4 * ks + kg) ^ r16) << 4)); acc[mt] = __builtin_amdgcn_mfma_f32_16x16x32_f16(af, bf, acc[mt], 0, 0, 0); }
        }
        __syncthreads();
    }
    const float bj = kh ? 0.f : P.b_ada[n0 + r16]; float* mo = P.ws + (kh ? W_MOD2 : W_MOD);
#pragma unroll
    for (int mt = 0; mt < MT; ++mt)
#pragma unroll
        for (int i = 0; i < 4; ++i) { const int seq = 16 * mt + 4 * kg + i; if (seq < NSEQ) mo[(long)seq * 6144 + n0 + r16] = acc[mt][i] + bj; }
}
}


typedef float f32x4 __attribute__((ext_vector_type(4)));
typedef _Float16 h2_t __attribute__((ext_vector_type(2)));
typedef unsigned u32x4 __attribute__((ext_vector_type(4)));
typedef unsigned u32x2 __attribute__((ext_vector_type(2)));
__device__ __forceinline__ unsigned pk2h(float lo, float hi) { h2_t p; p.x = (_Float16)lo; p.y = (_Float16)hi; return __builtin_bit_cast(unsigned, p); }
__device__ __forceinline__ float wave_sum(float v) {
#pragma unroll
    for (int o = 1; o < 64; o <<= 1) v += __shfl_xor(v, o);
    return v;
}
#define LDS_WAIT() asm volatile("s_waitcnt lgkmcnt(0)" ::: "memory")

__device__ __forceinline__ void transpose_item(const float* W, int ldw, int K, _Float16* WT, int n0, int src0, int valid, int kb, LAS float* scr, int lane) {
    const int k0 = 64 * kb, c31 = lane & 31;
    float tv[32];
#pragma unroll
    for (int i = 0; i < 32; ++i) { const int kk = 2 * i + (lane >> 5); tv[i] = (c31 < valid) ? W[(size_t)(k0 + kk) * ldw + src0 + c31] : 0.f; }
#pragma unroll
    for (int i = 0; i < 32; ++i) { const int kk = 2 * i + (lane >> 5); scr[kk * 33 + c31] = tv[i]; }
    LDS_WAIT(); asm volatile("" ::: "memory");
    const int c = lane & 7;
#pragma unroll
    for (int j = 0; j < 4; ++j) { const int n = (lane >> 3) + 8 * j; const LAS float* sp = scr + (8 * c) * 33 + n;
        u32x4 o; o.x = pk2h(sp[0 * 33], sp[1 * 33]); o.y = pk2h(sp[2 * 33], sp[3 * 33]); o.z = pk2h(sp[4 * 33], sp[5 * 33]); o.w = pk2h(sp[6 * 33], sp[7 * 33]);
        *(u32x4*)(WT + (size_t)(n0 + n) * K + k0 + 8 * c) = o; }
    LDS_WAIT(); asm volatile("" ::: "memory");
}
__device__ __forceinline__ void h_row(const Params& P, int tok, int lane) {
    int seq, t, pos0; tokinfo(tok, seq, t, pos0);
    const f32x4* xr = (const f32x4*)xrow(P, tok) + lane;
    f32x4 v[8]; float s = 0.f;
#pragma unroll
    for (int j = 0; j < 8; ++j) { v[j] = xr[64 * j]; s += (v[j].x * v[j].x + v[j].y * v[j].y) + (v[j].z * v[j].z + v[j].w * v[j].w); }
    const float rstd = rsqrtf(wave_sum(s) * (1.0f / D) + 1e-6f);
    const float* mod = P.ws + W_MOD + (long)seq * 6144;
    _Float16* hrow = (_Float16*)(P.ws + W_H16) + (long)tok * D;
#pragma unroll
    for (int j = 0; j < 8; ++j) { const int idx = 4 * (64 * j + lane);
        const float* mod2 = mod + (W_MOD2 - W_MOD);
        const f32x4 np = *(const f32x4*)(P.npre + idx), sc = *(const f32x4*)(mod + D + idx) + *(const f32x4*)(mod2 + D + idx), sh = *(const f32x4*)(mod + idx) + *(const f32x4*)(mod2 + idx);
        const f32x4 h = v[j] * rstd * np * (1.0f + sc) + sh;
        u32x2 o; o.x = pk2h(h.x, h.y); o.y = pk2h(h.z, h.w);
        *(u32x2*)(hrow + idx) = o; }
}


__device__ __forceinline__ void mod_wave(const Params& P, int sgrp, int jb, int lane) {
    constexpr int NS = 6; static_assert(NSEQ % NS == 0, "sequence groups");
    const int j = jb * 64 + lane; float acc[NS];
#pragma unroll
    for (int q = 0; q < NS; ++q) acc[q] = 0.f;
    for (int k0 = 0; k0 < D; k0 += 64) {
        float sc[NS];
#pragma unroll
        for (int q = 0; q < NS; ++q) { const int seq = sgrp * NS + q; const float* c = seq < BATCH ? P.c_p + (long)seq * D : P.c_s + (long)(seq - BATCH) * D; sc[q] = silu_f(c[k0 + lane]); }
#pragma unroll
        for (int kk = 0; kk < 64; ++kk) { const float w = P.w_ada[(long)(k0 + kk) * 6144 + j];
#pragma unroll
            for (int q = 0; q < NS; ++q) acc[q] += __builtin_bit_cast(float, __builtin_amdgcn_readlane(__builtin_bit_cast(int, sc[q]), kk)) * w; }
    }
    const float bj = P.b_ada[j];
#pragma unroll
    for (int q = 0; q < NS; ++q) P.ws[W_MOD + (long)(sgrp * NS + q) * 6144 + j] = acc[q] + bj;
}
__device__ __forceinline__ void mixconv_row(const Params& P, int tok, int lane) {
    const f32x4* cr = (const f32x4*)(P.ws + W_CV + (long)tok * 1024) + lane;
    f32x4 v[4]; float s = 0.f;
#pragma unroll
    for (int j = 0; j < 4; ++j) { v[j] = cr[64 * j]; s += (v[j].x + v[j].y) + (v[j].z + v[j].w); }
    const float mu = wave_sum(s) * (1.0f / 1024); float q = 0.f;
#pragma unroll
    for (int j = 0; j < 4; ++j) { v[j] = v[j] - mu; q += (v[j].x * v[j].x + v[j].y * v[j].y) + (v[j].z * v[j].z + v[j].w * v[j].w); }
    const float rstd = rsqrtf(wave_sum(q) * (1.0f / 1024) + 1e-6f);
#pragma unroll
    for (int j = 0; j < 4; ++j) { const int c = 4 * (64 * j + lane);
        const f32x4 g = *(const f32x4*)(P.lng + c), b = *(const f32x4*)(P.lnb + c), z = *(const f32x4*)(P.ws + W_PROJ + (long)tok * LDP + C_ZC + c);
        const f32x4 ln = v[j] * rstd * g + b; f32x4 m;
        m.x = silu_f(ln.x) * silu_f(z.x); m.y = silu_f(ln.y) * silu_f(z.y); m.z = silu_f(ln.z) * silu_f(z.z); m.w = silu_f(ln.w) * silu_f(z.w);
        *(f32x4*)(P.ws + W_MIX + (long)tok * D + 1024 + c) = m;
        u32x2 o; o.x = pk2h(m.x, m.y); o.y = pk2h(m.z, m.w);
        *(u32x2*)((_Float16*)(P.ws + W_MIX16) + (long)tok * D + 1024 + c) = o; }
}
__device__ __forceinline__ void y_row(const Params& P, int tok, int lane) {
    int seq, t, pos0; tokinfo(tok, seq, t, pos0);
    const f32x4* orow = (const f32x4*)(P.ws + W_O2 + (long)tok * D) + lane; const f32x4* xr = (const f32x4*)xrow(P, tok) + lane;
    f32x4 v[8]; float s = 0.f;
#pragma unroll
    for (int j = 0; j < 8; ++j) { v[j] = orow[64 * j]; s += (v[j].x * v[j].x + v[j].y * v[j].y) + (v[j].z * v[j].z + v[j].w * v[j].w); }
    const float rstd = rsqrtf(wave_sum(s) * (1.0f / D) + 1e-6f);
    const float* gate = P.ws + W_MOD + (long)seq * 6144 + 2 * D;
    float* yrow = P.out + (tok < TOK_P ? O_YP + (long)tok * D : O_YS + (long)(tok - TOK_P) * D);
#pragma unroll
    for (int j = 0; j < 8; ++j) { const int idx = 4 * (64 * j + lane);
        const f32x4 g = *(const f32x4*)(gate + idx) + *(const f32x4*)(gate + (W_MOD2 - W_MOD) + idx), np = *(const f32x4*)(P.npost + idx), x = xr[64 * j];
        *(f32x4*)(yrow + idx) = x + g * (v[j] * rstd * np); }
}

__device__ __forceinline__ void combine_row(const Params& P, int tok, int lane) {
    const float* gt = P.ws + W_GATES + (long)tok * 32; const _Float16* zn = (const _Float16*)(P.ws + W_ZN16) + (long)tok * 1024;
    _Float16* mo = (_Float16*)(P.ws + W_MIX16) + (long)tok * D;
#pragma unroll
    for (int j = 0; j < 4; ++j) { const int c = 4 * (64 * j + lane), h = c >> 7; const float g0 = gt[h], g1 = gt[8 + h], g2 = gt[16 + h];
        const f32x4 a = *(const f32x4*)(P.ws + W_OCMP + (long)tok * 1024 + c), b = *(const f32x4*)(P.ws + W_OSLC + (long)tok * 1024 + c), w = *(const f32x4*)(P.ws + W_OWIN + (long)tok * 1024 + c);
        typedef _Float16 h4_t __attribute__((ext_vector_type(4))); const h4_t z = *(const h4_t*)(zn + c);
        const f32x4 o = a * g0 + b * g1 + w * g2;
        u32x2 r; r.x = pk2h(o.x * (float)z.x, o.y * (float)z.y); r.y = pk2h(o.z * (float)z.z, o.w * (float)z.w);
        *(u32x2*)(mo + c) = r; }
}

__global__ void __launch_bounds__(NTHREADS, 2) fwd_kernel(Params P) {
    extern __shared__ __attribute__((aligned(16))) unsigned char lds_raw[];
    LAS unsigned char* lds = (LAS unsigned char*)lds_raw;
    volatile LAS unsigned* misc = (volatile LAS unsigned*)(lds + LDS_MISC);
    if (threadIdx.x < 64) misc[threadIdx.x] = 0u;
    __syncthreads();
    XcdBarrier bar = xcd_barrier_post((unsigned*)P.ws + CW_BAR, misc + 8);
    const int G = gridDim.x;
#define OTID() ({ int t_ = threadIdx.x; asm volatile("" : "+v"(t_)); t_; })
#define RUN(n, fn) { const int t_ = OTID(); const long _n = (n), _g0 = (long)blockIdx.x * NTHREADS + t_, gsz_ = (long)G * NTHREADS; for (long _i = _g0; _i < _n; _i += gsz_) fn(P, _i); }
#define RUN_OFF(n, off, fn) { const int t_ = OTID(); const long _n = (n), _o = (off), _g0 = (long)blockIdx.x * NTHREADS + t_, gsz_ = (long)G * NTHREADS; for (long _i = _g0; _i < _n; _i += gsz_) fn(P, _i + _o); }
    {
    const int NMOD = G > 2 * modb::N_ITEMS ? modb::N_ITEMS : 0;
    if (NMOD == 0 || (int)blockIdx.x < NMOD) { for (int it = blockIdx.x; it < modb::N_ITEMS; it += (NMOD ? NMOD : G)) modb::mod_item(P, (char*)lds_raw, it); }
    if (NMOD == 0 || (int)blockIdx.x >= NMOD) {
        const int bx = (int)blockIdx.x - NMOD, GP = G - NMOD;
#define RUNP(n, fn) { const int t_ = OTID(); const long _n = (n), _g0 = (long)bx * NTHREADS + t_, gsz_ = (long)GP * NTHREADS; for (long _i = _g0; _i < _n; _i += gsz_) fn(P, _i); }
        RUNP(2L * 256 * 2048, it_wc16); RUNP(2L * 128 * 128, it_w2t16); RUNP(2L * 32 * 128, it_cconst_part);
#undef RUNP
        const int tid = OTID(), lane = tid & 63, wave = __builtin_amdgcn_readfirstlane(tid >> 6), gw = bx * NWAVES + wave, NGW = GP * NWAVES;
        LAS float* scr = (LAS float*)(lds + wave * 16384);
        constexpr int I_IN = (D / 64) * (LDP / 32), I_OUT = (D / 64) * (D / 32);
        for (int it = gw; it < I_IN + I_OUT; it += NGW) {
            if (it < I_IN) { const int kb = it / (LDP / 32), nb = it % (LDP / 32), n0 = 32 * nb; const int src = proj_src_col(n0);
                int valid = src < 0 ? 0 : 32; if (n0 == C_GATE) valid = 24;
                transpose_item(P.w_in, IN_COLS, D, (_Float16*)(P.ws + W_WTIN), n0, src < 0 ? 0 : src, valid, kb, scr, lane); }
            else { const int r = it - I_IN, kb = r / (D / 32), nb = r % (D / 32);
                transpose_item(P.w_out, D, D, (_Float16*)(P.ws + W_WTOUT), 32 * nb, 32 * nb, 32, kb, scr, lane); }
        }
    }
    }
    xcd_barrier(bar);
    {
    { const int tid = OTID(), lane = tid & 63, wave = __builtin_amdgcn_readfirstlane(tid >> 6), gw = blockIdx.x * NWAVES + wave, NGW = G * NWAVES;
      for (int tok = gw; tok < TOK; tok += NGW) h_row(P, tok, lane); }
    RUN(256L, it_cconst_fin);
    }
    xcd_barrier(bar);
    const bool cmp_first = (((int)blockIdx.x >> 3) & 1) == 0;
    if (cmp_first) for (int u = blockIdx.x; u < DEC_BATCH * 4; u += G) cmpb::compress_unit(P, (char*)lds_raw, BATCH + (u >> 2), u & 3);
    {
        pg8::Gemm g{(const pg8::bf16_t*)(P.ws + W_H16), (const pg8::bf16_t*)(P.ws + W_WTIN), TOK, LDP, D};
        pg8::StaticOrder S; S.init(TOK, LDP, G, (int)blockIdx.x);
        pg8::EpiProj E{P.ws, P.out};
        pg8::gemm_phase<pg8::EpiProj, pg8::StaticOrder, true, true>(lds, g, S, E);
    }
    {
        const int nun_ = (TOK / 256) * (LDP / 256), full_ = nun_ / G, rem_ = nun_ % G;
        int cw_ = 0, CW_ = G; if (rem_ > 0 && G - rem_ >= 32) { CW_ = G - rem_; cw_ = (int)blockIdx.x - rem_; }
        (void)full_;
        if (cw_ >= 0)
    {
        typedef float f4 __attribute__((ext_vector_type(4)));
        const int t_ = OTID(); const long g0 = (long)cw_ * NTHREADS + t_, gsz = (long)CW_ * NTHREADS;
        constexpr long PERW = (long)(KEEP_S - DEC_SEQ) * 128, NW_ = (long)DEC_BATCH * PERW, PERC = (long)(30 - DEC_SEQ) * 256, NC_ = (long)DEC_BATCH * PERC;
        for (long i0 = g0; i0 < NW_; i0 += 8 * gsz) { f4 v[8];
#pragma unroll
            for (int q = 0; q < 8; ++q) { const long i = i0 + q * gsz; if (i < NW_) { const long b = i / PERW, r = i % PERW; v[q] = ((const f4*)(P.swin + (b * PW + (PW + DEC_SEQ - KEEP_S)) * 512))[r]; } }
#pragma unroll
            for (int q = 0; q < 8; ++q) { const long i = i0 + q * gsz; if (i < NW_) { const long b = i / PERW, r = i % PERW; ((f4*)(P.out + O_WS + b * KEEP_S * 512))[r] = v[q]; } } }
        for (long i0 = g0; i0 < NC_; i0 += 8 * gsz) { f4 v[8];
#pragma unroll
            for (int q = 0; q < 8; ++q) { const long i = i0 + q * gsz; if (i < NC_) { const long b = i / PERC, r = i % PERC; v[q] = ((const f4*)(P.sconv + (b * 30 + DEC_SEQ) * 1024))[r]; } }
#pragma unroll
            for (int q = 0; q < 8; ++q) { const long i = i0 + q * gsz; if (i < NC_) { const long b = i / PERC, r = i % PERC; ((f4*)(P.out + O_CS + b * 30 * 1024))[r] = v[q]; } } }
    }
    }
    if (!cmp_first) for (int u = blockIdx.x; u < DEC_BATCH * 4; u += G) cmpb::compress_unit(P, (char*)lds_raw, BATCH + (u >> 2), u & 3);
    xcd_barrier(bar);
    RUN((long)BATCH * 30 * 1024, it_out_conv_p); RUN((long)DEC_BATCH * DEC_SEQ * 1024, it_out_conv_s_new);
    {
    {
        unsigned* qctr = (unsigned*)P.ws + CW_QATT + 64;
        constexpr int N_CMP = BATCH * 4, N_SAM = DEC_BATCH * 2, N_FW = BATCH * 8 * (SEQ / 256), N_MIX = N_SAM + N_FW, N_CVP = BATCH * (SEQ / 16), N_CVS = DEC_BATCH, N_ALL = N_CMP + N_MIX + N_CVP + N_CVS;
        static_assert(N_SAM == N_FW, "sample units and window blocks alternate one to one");
        for (int first_ = 1;; first_ = 0) {
            if (OTID() == 0) misc[16] = first_ ? blockIdx.x : (unsigned)G + atomicAdd(qctr, 1u);
            __syncthreads(); const int id = __builtin_amdgcn_readfirstlane((int)misc[16]); __syncthreads();
            if (id >= N_ALL) break;
            if (id < N_CMP) cmpb::compress_unit(P, (char*)lds_raw, id >> 2, id & 3);
            else if (id < N_CMP + N_MIX) { const int m = id - N_CMP, u = m >> 1;
                if ((m & 1) == 0) sam::sample_unit(P, (char*)lds_raw, u >> 1, u & 1);
                else {
                    const int qb = (SEQ / 256 - 1) - (u >> 5), bh = u & 31, bb = bh >> 3, h = bh & 7, gg = h >> 2; const long tok0 = (long)bb * SEQ + 256 * qb;
                    const _Float16* kvw = (const _Float16*)(P.ws + W_KVW16) + (long)bb * SEQ * 1536;
                    fa::BlockRef r; r.Q = (const _Float16*)(P.ws + W_Q16) + tok0 * 1024 + h * 128; r.K = kvw + 1024 + gg * 128; r.V = kvw + 1280 + gg * 128;
                    r.O = P.ws + W_OWIN + tok0 * 1024 + h * 128; r.sel = nullptr; r.P0 = 256 * qb; r.W = WINDOW + 1;
                    fa::Seam S; fa::swa_prime(r, (char*)lds_raw, S); fa::swa_block(r, r, SEQ, (char*)lds_raw, S); } }
            else if (id < N_CMP + N_MIX + N_CVP) { const int u = id - N_CMP - N_MIX; { const int t0_ = 16 * (u % (SEQ / 16)); if (t0_ < 30) cvb::conv_unit<16, true>(P, (char*)lds_raw, u / (SEQ / 16), t0_); else cvb::conv_unit<16, false>(P, (char*)lds_raw, u / (SEQ / 16), t0_); } }
            else { const int u = id - N_CMP - N_MIX - N_CVP; cvb::conv_unit<DEC_SEQ, true>(P, (char*)lds_raw, BATCH + u, 0); }
        }
    }
    }
    xcd_barrier(bar);
    for (int u = blockIdx.x; u < BATCH * 2 * (SEQ / 64); u += G) cmpa::unit(P, (char*)lds_raw, u / (2 * (SEQ / 64)), (u / (SEQ / 64)) & 1, u % (SEQ / 64));
    xcd_barrier(bar);
    {
        static_assert(SEQ == 2048 && BATCH == 4, "attention item table is written for 4 x 2048 prompt tokens");
        const int tid = OTID();
        char* flds = (char*)lds_raw;
        unsigned* qctr = (unsigned*)P.ws + CW_QATT;
        constexpr int NITEMS = 256;
#define QFETCH(dst) do { if (tid == 0) misc[16] = qfirst ? blockIdx.x : (unsigned)G + atomicAdd(qctr, 1u); qfirst = 0; __syncthreads(); dst = __builtin_amdgcn_readfirstlane((int)misc[16]); __syncthreads(); } while (0)
#define QDECODE(r, id_) do { const int seg = (id_) >> 5, bh = (id_) & 31, b = bh >> 3, h = bh & 7, g = h >> 2;                                   \
            const int qb = (SEQ / 256 - 1) - seg;                                                                                            \
            const long tok0 = (long)b * SEQ + 256 * qb;                                                                                      \
            const _Float16* kvw = (const _Float16*)(P.ws + W_KVW16) + (long)b * SEQ * 1536;                                                  \
            r.Q = (const _Float16*)(P.ws + W_Q16) + tok0 * 1024 + h * 128;                                                                   \
            r.K = kvw + 512 + g * 128; r.V = kvw + 768 + g * 128;                                                                            \
            r.O = P.ws + W_OSLC + tok0 * 1024 + h * 128;                                                                                     \
            r.sel = (const unsigned*)(P.ws + W_SEL) + (tok0 * 2 + g) * 2;                                                                    \
            r.P0 = 256 * qb; r.W = (1 << 30); } while (0)
        int qfirst = 1;
        constexpr int NGU = (TOK_S / 256) * (D / 256);
        int id; QFETCH(id);
        while (id < NGU) {
            pg8::Gemm g{(const pg8::bf16_t*)(P.ws + W_MIX16), (const pg8::bf16_t*)(P.ws + W_WTOUT), TOK, D, D};
            pg8::OneUnit S1{TOK_P / 256 + id / (D / 256), id % (D / 256)};
            pg8::EpiF32 E{P.ws + W_O2, D};
            pg8::gemm_phase<pg8::EpiF32, pg8::OneUnit, false, true>(lds, g, S1, E);
            QFETCH(id);
        }
        id -= NGU;
        if (id < NITEMS) {
            fa::BlockRef cur, nxt; QDECODE(cur, id); fa::Seam S;
            fa::swa_prime(cur, flds, S);
            for (;;) {
                int nid; QFETCH(nid); nid -= NGU; const bool last = nid >= NITEMS;
                if (last) nxt = cur; else QDECODE(nxt, nid);
                fa::swa_block(cur, nxt, SEQ, flds, S);
                if (last) break;
                cur = nxt;
            }
        }
#undef QFETCH
#undef QDECODE
    }
    xcd_barrier(bar);
    { const int t_ = OTID(), lane_ = t_ & 63, gw_ = blockIdx.x * NWAVES + __builtin_amdgcn_readfirstlane(t_ >> 6); for (int tok_ = gw_; tok_ < TOK_P; tok_ += G * NWAVES) combine_row(P, tok_, lane_); }
    xcd_barrier(bar);
    {
        pg8::Gemm g{(const pg8::bf16_t*)(P.ws + W_MIX16), (const pg8::bf16_t*)(P.ws + W_WTOUT), TOK_P, D, D};
        pg8::StaticOrder S; S.init(TOK_P, D, G, (int)blockIdx.x);
        pg8::EpiF32 E{P.ws + W_O2, D};
        pg8::gemm_phase<pg8::EpiF32, pg8::StaticOrder, true, true>(lds, g, S, E);
    }
    xcd_barrier(bar);
    WAVE_ROWS(y_row);
#undef RUN
#undef RUN_OFF
}

extern "C" void kernel_launch(void* const* d_in, const int* in_sizes, int n_in, void* d_out, int out_size, void* d_ws, size_t ws_size, hipStream_t stream) {
    static int grid = 0;
    if (grid == 0) {
        int dev = 0, cus = 0;
        if (hipGetDevice(&dev) != hipSuccess || hipDeviceGetAttribute(&cus, hipDeviceAttributeMultiprocessorCount, dev) != hipSuccess) { grid = -1; return; }
        if (hipFuncSetAttribute((const void*)fwd_kernel, hipFuncAttributeMaxDynamicSharedMemorySize, LDS_BYTES) != hipSuccess) { grid = -1; return; }
        if ((size_t)W_END * 4 > ws_size || out_size != (int)O_END) { fprintf(stderr, "kernel_launch: ws/out size mismatch (%zu needed, %zu given; out %d vs %ld)\n", (size_t)W_END * 4, ws_size, out_size, (long)O_END); grid = -1; return; }
        (void)hipGetLastError();
        grid = cus;
    }
    if (grid < 0) return;
    (void)hipMemsetAsync(d_ws, 0, 65536, stream);
    Params p{};
    p.x_p = (const float*)d_in[0]; p.x_s = (const float*)d_in[1]; p.c_p = (const float*)d_in[2]; p.c_s = (const float*)d_in[3]; p.cache = (const float*)d_in[4];
    p.ptab = (const int*)d_in[5]; p.swin = (const float*)d_in[6]; p.sconv = (const float*)d_in[7]; p.w_ada = (const float*)d_in[8]; p.b_ada = (const float*)d_in[9];
    p.npre = (const float*)d_in[10]; p.npost = (const float*)d_in[11]; p.w_in = (const float*)d_in[12]; p.pe = (const float*)d_in[13]; p.w1 = (const float*)d_in[14];
    p.b1 = (const float*)d_in[15]; p.w2 = (const float*)d_in[16]; p.b2 = (const float*)d_in[17]; p.dw = (const float*)d_in[18]; p.db = (const float*)d_in[19];
    p.lng = (const float*)d_in[20]; p.lnb = (const float*)d_in[21]; p.w_out = (const float*)d_in[22];
    p.out = (float*)d_out; p.ws = (float*)d_ws;
    hipLaunchKernelGGL(fwd_kernel, dim3(grid), dim3(NTHREADS), LDS_BYTES, stream, p);
}
#endif
```

```cpp
#ifndef CPU_TEST
#include <hip/hip_runtime.h>
#endif
#include <stdint.h>
#include <stddef.h>
#include <math.h>
#include <stdio.h>

#ifdef CPU_TEST
#define __device__
#define __host__
#define __forceinline__ inline
static inline float rsqrtf(float x) { return 1.0f / sqrtf(x); }
#endif

#ifndef CFG_BATCH
#define CFG_BATCH 4
#define CFG_SEQ 2048
#define CFG_DEC_BATCH 128
#define CFG_DEC_SEQ 4
#define CFG_PAST 2048
#endif
namespace cfg {
constexpr long al64(long x) { return (x + 63) & ~63L; }
constexpr int D = 2048, BATCH = CFG_BATCH, SEQ = CFG_SEQ, DEC_BATCH = CFG_DEC_BATCH, DEC_SEQ = CFG_DEC_SEQ, PAST = CFG_PAST, PAGE = 128;
constexpr int NPAGES = PAST / PAGE;
constexpr int HD = 128, NH = 8, NG = 2, NSA_W = 1024, CONV_C = 1024, WINDOW = 512, CONVW = 31;
constexpr int IN_COLS = 6680;
constexpr int C_Q = 0, C_KV = 1024, C_WIN = 2048, C_GATE = 2560, C_ZN = 2816, C_GL = 3840, C_ZC = 5888, LDP = 6912;
constexpr int TOK_P = BATCH * SEQ, TOK_S = DEC_BATCH * DEC_SEQ, TOK = TOK_P + TOK_S, NSEQ = BATCH + DEC_BATCH;
constexpr int PW = PAST < WINDOW ? PAST : WINDOW;
constexpr int L_P = SEQ, L_S = PAST + DEC_SEQ, LMAX = L_P > L_S ? L_P : L_S;
constexpr int NCMP_P = (L_P - 32) / 16 + 1, NCMP_S = (L_S - 32) / 16 + 1, NCMPX = NCMP_P > NCMP_S ? NCMP_P : NCMP_S;
constexpr int NSEL_P = (L_P + 63) / 64, NSEL_S = (L_S + 63) / 64, NSELX = NSEL_P > NSEL_S ? NSEL_P : NSEL_S;
constexpr int KEEP_P = SEQ < WINDOW ? SEQ : WINDOW, KEEP_S = (PW + DEC_SEQ) < WINDOW ? (PW + DEC_SEQ) : WINDOW;
constexpr int NWK = WINDOW + 1;
constexpr long O_YP = 0, O_YS = O_YP + (long)TOK_P * D, O_KVP = O_YS + (long)TOK_S * D, O_KVS = O_KVP + (long)TOK_P * 1024, O_WP = O_KVS + (long)TOK_S * 1024,
               O_WS = O_WP + (long)BATCH * KEEP_P * 512, O_CP = O_WS + (long)DEC_BATCH * KEEP_S * 512, O_CS = O_CP + (long)BATCH * 30 * 1024, O_END = O_CS + (long)DEC_BATCH * 30 * 1024;
constexpr long W_CTL = 0, W_MOD = 16384, W_RSTD = al64(W_MOD + (long)NSEQ * 6144), W_H = al64(W_RSTD + TOK), W_PROJ = al64(W_H + (long)TOK * D), W_HCMP = al64(W_PROJ + (long)TOK * LDP),
               W_KC = al64(W_HCMP + (long)NSEQ * NCMPX * 512), W_PC = al64(W_KC + (long)NSEQ * NCMPX * 512), W_OCMP = al64(W_PC + (long)TOK * 8 * NCMPX), W_IMP = al64(W_OCMP + (long)TOK * 1024),
               W_SEL = al64(W_IMP + (long)TOK * 2 * NSELX), W_SSLC = al64(W_SEL + (long)TOK * 4), W_OSLC = al64(W_SSLC + (long)TOK * 8 * LMAX), W_SWIN = al64(W_OSLC + (long)TOK * 1024),
               W_OWIN = al64(W_SWIN + (long)TOK * 8 * NWK), W_U = al64(W_OWIN + (long)TOK * 1024), W_CV = al64(W_U + (long)TOK * 1024), W_CVST = al64(W_CV + (long)TOK * 1024), W_MIX = al64(W_CVST + (long)TOK * 2),
               W_O2 = al64(W_MIX + (long)TOK * D), W_RSTD2 = al64(W_O2 + (long)TOK * D),
               W_H16 = al64(W_RSTD2 + TOK), W_MIX16 = al64(W_H16 + (long)TOK * D / 2), W_WTIN = al64(W_MIX16 + (long)TOK * D / 2), W_WTOUT = al64(W_WTIN + (long)LDP * D / 2),
               W_Q16 = al64(W_WTOUT + (long)D * D / 2), W_KVW16 = al64(W_Q16 + (long)TOK * 1024 / 2),
               W_WC16 = al64(W_KVW16 + (long)TOK * 1536 / 2), W_W2T16 = al64(W_WC16 + 2L * 256 * 2048 / 2), W_CCONST = al64(W_W2T16 + 2L * 128 * 128 / 2),
               W_CCPART = al64(W_CCONST + 256), W_MOD2 = al64(W_CCPART + 2 * 32 * 128), W_GATES = al64(W_MOD2 + (long)NSEQ * 6144), W_ZN16 = al64(W_GATES + (long)TOK * 32), W_ZC16 = al64(W_ZN16 + (long)TOK * 1024 / 2),
               W_END = al64(W_ZC16 + (long)TOK * 1024 / 2);
}
using namespace cfg;

struct Params {
    const float *x_p, *x_s, *c_p, *c_s, *cache; const int* ptab; const float *swin, *sconv, *w_ada, *b_ada, *npre, *npost, *w_in, *pe, *w1, *b1, *w2, *b2, *dw, *db, *lng, *lnb, *w_out;
    float* out; float* ws;
};

#define NEG_BIG (-1e30f)
__device__ __forceinline__ float silu_f(float x) { return x / (1.0f + expf(-x)); }
__device__ __forceinline__ float sigmoid_f(float x) { return 1.0f / (1.0f + expf(-x)); }

__device__ __forceinline__ void tokinfo(int tok, int& seq, int& t, int& pos0) {
    if (tok < TOK_P) { seq = tok / SEQ; t = tok % SEQ; pos0 = 0; }
    else { const int r = tok - TOK_P; seq = BATCH + r / DEC_SEQ; t = r % DEC_SEQ; pos0 = PAST; }
}
__device__ __forceinline__ int tok_of(int seq, int t) { return seq < BATCH ? seq * SEQ + t : TOK_P + (seq - BATCH) * DEC_SEQ + t; }
__device__ __forceinline__ const float* xrow(const Params& P, int tok) { return tok < TOK_P ? P.x_p + (long)tok * D : P.x_s + (long)(tok - TOK_P) * D; }
__device__ __forceinline__ const float* kvrow(const Params& P, int seq, int pos) {
    if (seq < BATCH) return P.ws + W_PROJ + (long)tok_of(seq, pos) * LDP + C_KV;
    if (pos < PAST) { const int b = seq - BATCH; const int pg = P.ptab[b * NPAGES + pos / PAGE]; return P.cache + ((long)pg * PAGE + pos % PAGE) * 1024; }
    return P.ws + W_PROJ + (long)tok_of(seq, pos - PAST) * LDP + C_KV;
}
__device__ __forceinline__ const float* winrow(const Params& P, int seq, int pos) {
    if (seq < BATCH) return P.ws + W_PROJ + (long)tok_of(seq, pos) * LDP + C_WIN;
    if (pos < PAST) { const int b = seq - BATCH; return P.swin + ((long)b * PW + (pos - (PAST - PW))) * 512; }
    return P.ws + W_PROJ + (long)tok_of(seq, pos - PAST) * LDP + C_WIN;
}
__device__ __forceinline__ float uall(const Params& P, int seq, int idx, int c) {
    if (idx < 30) return seq < BATCH ? 0.0f : P.sconv[((long)(seq - BATCH) * 30 + idx) * 1024 + c];
    return P.ws[W_U + (long)tok_of(seq, idx - 30) * 1024 + c];
}

__device__ __forceinline__ void it_mod(const Params& P, long i) {
    const int seq = (int)(i / 6144), j = (int)(i % 6144);
    const float* c = seq < BATCH ? P.c_p + (long)seq * D : P.c_s + (long)(seq - BATCH) * D;
    float acc = 0.f;
    for (int k = 0; k < D; ++k) acc += silu_f(c[k]) * P.w_ada[(long)k * 6144 + j];
    P.ws[W_MOD + i] = acc + P.b_ada[j];
}
__device__ __forceinline__ void it_rstd(const Params& P, long i) {
    const float* x = xrow(P, (int)i); float s = 0.f;
    for (int k = 0; k < D; ++k) s += x[k] * x[k];
    P.ws[W_RSTD + i] = rsqrtf(s * (1.0f / D) + 1e-6f);
}
__device__ __forceinline__ void it_h(const Params& P, long i) {
    const int tok = (int)(i / D), k = (int)(i % D); int seq, t, pos0; tokinfo(tok, seq, t, pos0);
    const float* mod = P.ws + W_MOD + (long)seq * 6144;
    P.ws[W_H + i] = xrow(P, tok)[k] * P.ws[W_RSTD + tok] * P.npre[k] * (1.0f + mod[D + k]) + mod[k];
}
__host__ __device__ __forceinline__ int proj_src_col(int n) {
    if (n < C_GATE) return n;
    if (n < C_ZN) return (n - C_GATE) < 24 ? 2560 + (n - C_GATE) : -1;
    if (n < C_GL) return 2584 + (n - C_ZN);
    if (n < C_ZC) { const int r = n - C_GL, tt = r >> 8, w = r & 255; return w < 128 ? 3608 + 128 * tt + w : 4632 + 128 * tt + (w - 128); }
    return 5656 + (n - C_ZC);
}
__device__ __forceinline__ void it_proj(const Params& P, long i) {
    const int tok = (int)(i / LDP), n = (int)(i % LDP), src = proj_src_col(n);
    const float* h = P.ws + W_H + (long)tok * D; float acc = 0.f;
    if (src >= 0) for (int k = 0; k < D; ++k) acc += h[k] * P.w_in[(long)k * IN_COLS + src];
    P.ws[W_PROJ + (long)tok * LDP + n] = acc;
}
__device__ __forceinline__ void it_out_kv(const Params& P, long i) {
    const int tok = (int)(i / 1024), c = (int)(i % 1024);
    P.out[(tok < TOK_P ? O_KVP + (long)tok * 1024 : O_KVS + (long)(tok - TOK_P) * 1024) + c] = P.ws[W_PROJ + (long)tok * LDP + C_KV + c];
}
__device__ __forceinline__ void it_out_win_p(const Params& P, long i) {
    const int c = (int)(i % 512); const long r = i / 512; const int ii = (int)(r % KEEP_P), b = (int)(r / KEEP_P);
    P.out[O_WP + i] = winrow(P, b, 0 + SEQ - KEEP_P + ii)[c];
}
__device__ __forceinline__ void it_out_win_s(const Params& P, long i) {
    const int c = (int)(i % 512); const long r = i / 512; const int ii = (int)(r % KEEP_S), b = (int)(r / KEEP_S);
    P.out[O_WS + i] = winrow(P, BATCH + b, PAST + DEC_SEQ - KEEP_S + ii)[c];
}
__device__ __forceinline__ void it_u(const Params& P, long i) {
    const int tok = (int)(i / 1024), c = (int)(i % 1024); const float* pr = P.ws + W_PROJ + (long)tok * LDP;
    P.ws[W_U + i] = pr[C_GL + 256 * (c >> 7) + (c & 127)] * sigmoid_f(pr[C_GL + 256 * (c >> 7) + 128 + (c & 127)]);
}
__device__ __forceinline__ void it_out_conv_p(const Params& P, long i) {
    const int c = (int)(i % 1024); const long r = i / 1024; const int ii = (int)(r % 30), b = (int)(r / 30);
    P.out[O_CP + i] = uall(P, b, SEQ + ii, c);
}
__device__ __forceinline__ void it_out_conv_s(const Params& P, long i) {
    const int c = (int)(i % 1024); const long r = i / 1024; const int ii = (int)(r % 30), b = (int)(r / 30);
    P.out[O_CS + i] = uall(P, BATCH + b, DEC_SEQ + ii, c);
}
__device__ __forceinline__ void it_hcmp(const Params& P, long i) {
    const int e = (int)(i % 128); long r = i / 128; const int sg = (int)(r % 4); r /= 4; const int n = (int)(r % NCMPX), seq = (int)(r / NCMPX);
    const int ncmp = seq < BATCH ? NCMP_P : NCMP_S; if (n >= ncmp) return;
    const int s = sg >> 1;
    float acc = P.b1[s * 128 + e];
    for (int l = 0; l < 32; ++l) {
        const float* kv = kvrow(P, seq, 16 * n + l) + sg * 128;
        const float* pe = P.pe + (s * 32 + l) * 128; const float* w = P.w1 + ((long)(s * 32 + l) * 128) * 128 + e;
        for (int d = 0; d < 128; ++d) acc += (kv[d] + pe[d]) * w[(long)d * 128];
    }
    P.ws[W_HCMP + i] = acc;
}
__device__ __forceinline__ void it_kc(const Params& P, long i) {
    const int f = (int)(i % 128); long r = i / 128; const int sg = (int)(r % 4); r /= 4; const int n = (int)(r % NCMPX), seq = (int)(r / NCMPX);
    const int ncmp = seq < BATCH ? NCMP_P : NCMP_S; if (n >= ncmp) return;
    const int s = sg >> 1; const float* h = P.ws + W_HCMP + (i - f);
    float acc = P.b2[s * 128 + f];
    for (int e = 0; e < 128; ++e) acc += silu_f(h[e]) * P.w2[((long)s * 128 + e) * 128 + f];
    P.ws[W_KC + i] = acc;
}
__device__ __forceinline__ void it_cmp_score(const Params& P, long i) {
    const int n = (int)(i % NCMPX); long r = i / NCMPX; const int h = (int)(r % 8), tok = (int)(r / 8); int seq, t, pos0; tokinfo(tok, seq, t, pos0);
    const int ncmp = seq < BATCH ? NCMP_P : NCMP_S, qpos = pos0 + t;
    float sc = NEG_BIG;
    if (n < ncmp && 16 * n + 31 <= qpos) {
        const float* q = P.ws + W_PROJ + (long)tok * LDP + C_Q + h * 128; const float* k = P.ws + W_KC + (((long)seq * NCMPX + n) * 4 + 0 * 2 + (h >> 2)) * 128;
        float acc = 0.f; for (int d = 0; d < 128; ++d) acc += q[d] * k[d];
        sc = acc * 0.08838834764831845f;
    }
    P.ws[W_PC + i] = sc;
}
__device__ __forceinline__ void softmax_row(float* s, int n) {
    float m = NEG_BIG; for (int j = 0; j < n; ++j) m = fmaxf(m, s[j]);
    float sum = 0.f; for (int j = 0; j < n; ++j) { const float v = s[j]; sum += (v > -0.5e30f) ? expf(v - m) : 0.f; }
    const float inv = 1.0f / fmaxf(sum, 1e-30f);
    for (int j = 0; j < n; ++j) { const float v = s[j]; s[j] = (v > -0.5e30f) ? expf(v - m) * inv : 0.f; }
}
__device__ __forceinline__ void it_cmp_softmax(const Params& P, long i) { softmax_row(P.ws + W_PC + i * NCMPX, NCMPX); }
__device__ __forceinline__ void it_ocmp(const Params& P, long i) {
    const int c = (int)(i % 1024), tok = (int)(i / 1024), h = c >> 7, d = c & 127; int seq, t, pos0; tokinfo(tok, seq, t, pos0);
    const int ncmp = seq < BATCH ? NCMP_P : NCMP_S; const float* p = P.ws + W_PC + ((long)tok * 8 + h) * NCMPX;
    float acc = 0.f;
    for (int n = 0; n < ncmp; ++n) acc += p[n] * P.ws[W_KC + (((long)seq * NCMPX + n) * 4 + 1 * 2 + (h >> 2)) * 128 + d];
    P.ws[W_OCMP + i] = acc;
}
__device__ __forceinline__ void it_imp(const Params& P, long i) {
    const int j = (int)(i % NSELX); long r = i / NSELX; const int g = (int)(r % 2), tok = (int)(r / 2); int seq, t, pos0; tokinfo(tok, seq, t, pos0);
    const int ncmp = seq < BATCH ? NCMP_P : NCMP_S;
    int n0 = 4 * j - 1; if (n0 < 0) n0 = 0; int n1 = 4 * j + 3; if (n1 > ncmp - 1) n1 = ncmp - 1;
    float acc = 0.f;
    for (int n = n0; n <= n1; ++n) { float s4 = 0.f; for (int rr = 0; rr < 4; ++rr) s4 += P.ws[W_PC + ((long)tok * 8 + g * 4 + rr) * NCMPX + n]; acc += s4; }
    P.ws[W_IMP + i] = acc;
}
__device__ __forceinline__ void it_select(const Params& P, long i) {
    const int g = (int)(i % 2), tok = (int)(i / 2); int seq, t, pos0; tokinfo(tok, seq, t, pos0);
    const int nsel = seq < BATCH ? NSEL_P : NSEL_S, qpos = pos0 + t, cur = qpos / 64;
    const float* imp = P.ws + W_IMP + ((long)tok * 2 + g) * NSELX;
    unsigned long long chosen = 0ull;
    const int K = nsel < 16 ? nsel : 16;
    for (int it = 0; it < K; ++it) {
        float best = -3e38f; int bj = -1;
        for (int j = 0; j < nsel; ++j) {
            if ((chosen >> j) & 1ull) continue;
            const bool allowed = j * 64 <= qpos; const bool forced = (j == 0) || (j == cur) || (j == cur - 1);
            const float sc = allowed ? imp[j] + (forced ? 1e6f : 0.0f) : NEG_BIG;
            if (sc > best) { best = sc; bj = j; }
        }
        if (bj < 0 || !(best > -0.5e30f)) break;
        chosen |= 1ull << bj;
    }
    unsigned* o = (unsigned*)(P.ws + W_SEL) + ((long)tok * 2 + g) * 2;
    o[0] = (unsigned)chosen; o[1] = (unsigned)(chosen >> 32);
}
__device__ __forceinline__ void it_slc_score(const Params& P, long i) {
    const int pos = (int)(i % LMAX); long r = i / LMAX; const int h = (int)(r % 8), tok = (int)(r / 8); int seq, t, pos0; tokinfo(tok, seq, t, pos0);
    const int qpos = pos0 + t, g = h >> 2;
    const unsigned* sm = (const unsigned*)(P.ws + W_SEL) + ((long)tok * 2 + g) * 2;
    const unsigned long long mask = (unsigned long long)sm[0] | ((unsigned long long)sm[1] << 32);
    float sc = NEG_BIG;
    if (pos <= qpos && ((mask >> (pos >> 6)) & 1ull)) {
        const float* q = P.ws + W_PROJ + (long)tok * LDP + C_Q + h * 128; const float* k = kvrow(P, seq, pos) + (2 * 2 + g) * 128;
        float acc = 0.f; for (int d = 0; d < 128; ++d) acc += q[d] * k[d];
        sc = acc * 0.08838834764831845f;
    }
    P.ws[W_SSLC + i] = sc;
}
__device__ __forceinline__ void it_slc_softmax(const Params& P, long i) {
    const int tok = (int)(i / 8); int seq, t, pos0; tokinfo(tok, seq, t, pos0);
    softmax_row(P.ws + W_SSLC + i * LMAX, pos0 + t + 1);
}
__device__ __forceinline__ void it_oslc(const Params& P, long i) {
    const int c = (int)(i % 1024), tok = (int)(i / 1024), h = c >> 7, d = c & 127; int seq, t, pos0; tokinfo(tok, seq, t, pos0);
    const int qpos = pos0 + t, g = h >> 2; const float* p = P.ws + W_SSLC + ((long)tok * 8 + h) * LMAX;
    float acc = 0.f;
    for (int pos = 0; pos <= qpos; ++pos) { const float pv = p[pos]; if (pv != 0.f) acc += pv * kvrow(P, seq, pos)[(3 * 2 + g) * 128 + d]; }
    P.ws[W_OSLC + i] = acc;
}
__device__ __forceinline__ void it_win_score(const Params& P, long i) {
    const int w = (int)(i % NWK); long r = i / NWK; const int h = (int)(r % 8), tok = (int)(r / 8); int seq, t, pos0; tokinfo(tok, seq, t, pos0);
    const int qpos = pos0 + t, g = h >> 2, pos = qpos - WINDOW + w;
    float sc = NEG_BIG;
    if (pos >= 0 && pos >= pos0 - PW) {
        const float* q = P.ws + W_PROJ + (long)tok * LDP + C_Q + h * 128; const float* k = winrow(P, seq, pos) + (0 * 2 + g) * 128;
        float acc = 0.f; for (int d = 0; d < 128; ++d) acc += q[d] * k[d];
        sc = acc * 0.08838834764831845f;
    }
    P.ws[W_SWIN + i] = sc;
}
__device__ __forceinline__ void it_win_softmax(const Params& P, long i) { softmax_row(P.ws + W_SWIN + i * NWK, NWK); }
__device__ __forceinline__ void it_owin(const Params& P, long i) {
    const int c = (int)(i % 1024), tok = (int)(i / 1024), h = c >> 7, d = c & 127; int seq, t, pos0; tokinfo(tok, seq, t, pos0);
    const int qpos = pos0 + t, g = h >> 2; const float* p = P.ws + W_SWIN + ((long)tok * 8 + h) * NWK;
    float acc = 0.f;
    for (int w = 0; w < NWK; ++w) { const float pv = p[w]; if (pv != 0.f) acc += pv * winrow(P, seq, qpos - WINDOW + w)[(1 * 2 + g) * 128 + d]; }
    P.ws[W_OWIN + i] = acc;
}
__device__ __forceinline__ void it_combine(const Params& P, long i) {
    const int c = (int)(i % 1024), tok = (int)(i / 1024), h = c >> 7; const float* pr = P.ws + W_PROJ + (long)tok * LDP;
    const float g0 = sigmoid_f(pr[C_GATE + 0 * 8 + h]), g1 = sigmoid_f(pr[C_GATE + 1 * 8 + h]), g2 = sigmoid_f(pr[C_GATE + 2 * 8 + h]);
    const float o = g0 * P.ws[W_OCMP + i] + g1 * P.ws[W_OSLC + i] + g2 * P.ws[W_OWIN + i];
    const float mv = o * silu_f(pr[C_ZN + c]);
    P.ws[W_MIX + (long)tok * D + c] = mv;
#ifndef CPU_TEST
    ((_Float16*)(P.ws + W_MIX16))[(long)tok * D + c] = (_Float16)mv;
#endif
}
__device__ __forceinline__ void it_cv(const Params& P, long i) {
    const int c = (int)(i % 1024), tok = (int)(i / 1024); int seq, t, pos0; tokinfo(tok, seq, t, pos0);
    float acc = P.db[c];
    for (int k = 0; k < CONVW; ++k) acc += P.dw[k * 1024 + c] * uall(P, seq, t + k, c);
    P.ws[W_CV + i] = acc;
}
__device__ __forceinline__ void it_cvstat(const Params& P, long i) {
    const float* cv = P.ws + W_CV + i * 1024; float s = 0.f; for (int c = 0; c < 1024; ++c) s += cv[c];
    const float mu = s * (1.0f / 1024); float v = 0.f; for (int c = 0; c < 1024; ++c) { const float d = cv[c] - mu; v += d * d; }
    P.ws[W_CVST + i * 2] = mu; P.ws[W_CVST + i * 2 + 1] = rsqrtf(v * (1.0f / 1024) + 1e-6f);
}
__device__ __forceinline__ void it_mixconv(const Params& P, long i) {
    const int c = (int)(i % 1024), tok = (int)(i / 1024);
    const float ln = (P.ws[W_CV + i] - P.ws[W_CVST + tok * 2]) * P.ws[W_CVST + tok * 2 + 1] * P.lng[c] + P.lnb[c];
    const float mv = silu_f(ln) * silu_f(P.ws[W_PROJ + (long)tok * LDP + C_ZC + c]);
    P.ws[W_MIX + (long)tok * D + 1024 + c] = mv;
#ifndef CPU_TEST
    ((_Float16*)(P.ws + W_MIX16))[(long)tok * D + 1024 + c] = (_Float16)mv;
#endif
}
__device__ __forceinline__ void it_o2(const Params& P, long i) {
    const int tok = (int)(i / D), n = (int)(i % D); const float* m = P.ws + W_MIX + (long)tok * D; float acc = 0.f;
    for (int k = 0; k < D; ++k) acc += m[k] * P.w_out[(long)k * D + n];
    P.ws[W_O2 + i] = acc;
}
__device__ __forceinline__ void it_rstd2(const Params& P, long i) {
    const float* x = P.ws + W_O2 + i * D; float s = 0.f; for (int k = 0; k < D; ++k) s += x[k] * x[k];
    P.ws[W_RSTD2 + i] = rsqrtf(s * (1.0f / D) + 1e-6f);
}
__device__ __forceinline__ void it_y(const Params& P, long i) {
    const int tok = (int)(i / D), n = (int)(i % D); int seq, t, pos0; tokinfo(tok, seq, t, pos0);
    const float gate = P.ws[W_MOD + (long)seq * 6144 + 2 * D + n];
    const float y = xrow(P, tok)[n] + gate * (P.ws[W_O2 + i] * P.ws[W_RSTD2 + tok] * P.npost[n]);
    P.out[(tok < TOK_P ? O_YP + (long)tok * D : O_YS + (long)(tok - TOK_P) * D) + n] = y;
}

#ifndef CPU_TEST
__device__ __forceinline__ void it_wc16(const Params& P, long i) {
    const int k = (int)(i % 2048), n = (int)((i / 2048) % 256), s = (int)(i / (2048 * 256)), lp = k >> 7, d = k & 127, l = n < 128 ? lp : 16 + lp, e = n & 127;
    ((_Float16*)(P.ws + W_WC16))[i] = (_Float16)P.w1[(((long)s * 32 + l) * 128 + d) * 128 + e];
}
__device__ __forceinline__ void it_w2t16(const Params& P, long i) {
    const int e = (int)(i % 128), f = (int)((i / 128) % 128), s = (int)(i / (128 * 128));
    ((_Float16*)(P.ws + W_W2T16))[i] = (_Float16)P.w2[((long)s * 128 + e) * 128 + f];
}
__device__ __forceinline__ void it_cconst_part(const Params& P, long i) {
    const int e = (int)(i & 127), ch = (int)((i >> 7) & 31), s = (int)(i >> 12); float acc = 0.f;
    for (int q = 0; q < 128; ++q) { const int ld = ch * 128 + q; acc += P.pe[s * 4096 + ld] * P.w1[((long)s * 4096 + ld) * 128 + e]; }
    P.ws[W_CCPART + i] = acc;
}
__device__ __forceinline__ void it_cconst_fin(const Params& P, long i) {
    const int e = (int)(i & 127), s = (int)(i >> 7); float acc = P.b1[i];
    for (int ch = 0; ch < 32; ++ch) acc += P.ws[W_CCPART + ((long)(s * 32 + ch) << 7) + e];
    P.ws[W_CCONST + i] = acc;
}
__device__ __forceinline__ void it_copy_win_state(const Params& P, long i) {
    typedef float f4 __attribute__((ext_vector_type(4)));
    constexpr long PER = (long)(KEEP_S - DEC_SEQ) * 128; const long b = i / PER, r = i % PER;
    ((f4*)(P.out + O_WS + b * KEEP_S * 512))[r] = ((const f4*)(P.swin + (b * PW + (PW + DEC_SEQ - KEEP_S)) * 512))[r];
}
__device__ __forceinline__ void it_copy_conv_state(const Params& P, long i) {
    typedef float f4 __attribute__((ext_vector_type(4)));
    constexpr long PER = (long)(30 - DEC_SEQ) * 256; const long b = i / PER, r = i % PER;
    ((f4*)(P.out + O_CS + b * 30 * 1024))[r] = ((const f4*)(P.sconv + (b * 30 + DEC_SEQ) * 1024))[r];
}
__device__ __forceinline__ void it_out_win_s_new(const Params& P, long i) {
    const int c = (int)(i % 512); const long r = i / 512; const int t = (int)(r % DEC_SEQ), b = (int)(r / DEC_SEQ);
    P.out[O_WS + ((long)b * KEEP_S + (KEEP_S - DEC_SEQ) + t) * 512 + c] = P.ws[W_PROJ + (long)tok_of(BATCH + b, t) * LDP + C_WIN + c];
}
__device__ __forceinline__ void it_out_conv_s_new(const Params& P, long i) {
    const int c = (int)(i % 1024); const long r = i / 1024; const int t = (int)(r % DEC_SEQ), b = (int)(r / DEC_SEQ);
    P.out[O_CS + ((long)b * 30 + (30 - DEC_SEQ) + t) * 1024 + c] = P.ws[W_U + (long)tok_of(BATCH + b, t) * 1024 + c];
}
__device__ __forceinline__ void it_cvt_q(const Params& P, long i) { const long tok = i / 1024; const int c = (int)(i % 1024); ((_Float16*)(P.ws + W_Q16))[i] = (_Float16)P.ws[W_PROJ + tok * LDP + C_Q + c]; }
__device__ __forceinline__ void it_cvt_kvw(const Params& P, long i) { const long tok = i / 1536; const int c = (int)(i % 1536); ((_Float16*)(P.ws + W_KVW16))[i] = (_Float16)P.ws[W_PROJ + tok * LDP + C_KV + c]; }
#endif
#define N_PHASES 16
#ifdef CPU_TEST
#define ATT_TOK0 0
#define NAIVE_CMP(x) x
#define NAIVE_ROW(x) x
#define WAVE_ROWS(fn)
#else
#define ATT_TOK0 TOK_P
#define NAIVE_CMP(x)
#define NAIVE_ROW(x)
#define WAVE_ROWS(fn) { const int t_ = OTID(), lane_ = t_ & 63, gw_ = blockIdx.x * NWAVES + __builtin_amdgcn_readfirstlane(t_ >> 6); for (int tok_ = gw_; tok_ < TOK; tok_ += G * NWAVES) fn(P, tok_, lane_); }
#endif
#define PHASE_BODY(ph)                                                                                                                   \
    if (ph == 0) { RUN((long)NSEQ * 6144, it_mod); RUN((long)TOK, it_rstd); }                                                            \
    if (ph == 1) { RUN((long)TOK * D, it_h); }                                                                                           \
    if (ph == 2) { RUN((long)TOK * LDP, it_proj); }                                                                                  \
    if (ph == 3) { NAIVE_CMP(RUN((long)NSEQ * NCMPX * 512, it_hcmp)); RUN((long)TOK * 1024, it_u); RUN_OFF((long)(TOK - ATT_TOK0) * 8 * NWK, (long)ATT_TOK0 * 8 * NWK, it_win_score);          \
                   RUN((long)TOK * 1024, it_out_kv); RUN((long)BATCH * KEEP_P * 512, it_out_win_p); RUN((long)DEC_BATCH * KEEP_S * 512, it_out_win_s); } \
    if (ph == 4) { NAIVE_CMP(RUN((long)NSEQ * NCMPX * 512, it_kc)); RUN((long)TOK * 1024, it_cv); RUN_OFF((long)(TOK - ATT_TOK0) * 8, (long)ATT_TOK0 * 8, it_win_softmax);               \
                   RUN((long)BATCH * 30 * 1024, it_out_conv_p); RUN((long)DEC_BATCH * 30 * 1024, it_out_conv_s); }                       \
    if (ph == 5) { RUN((long)TOK * 8 * NCMPX, it_cmp_score); NAIVE_ROW(RUN((long)TOK, it_cvstat)); RUN_OFF((long)(TOK - ATT_TOK0) * 1024, (long)ATT_TOK0 * 1024, it_owin); }                \
    if (ph == 6) { RUN((long)TOK * 8, it_cmp_softmax); NAIVE_ROW(RUN((long)TOK * 1024, it_mixconv)); WAVE_ROWS(mixconv_row); }                                              \
    if (ph == 7) { RUN((long)TOK * 1024, it_ocmp); RUN((long)TOK * 2 * NSELX, it_imp); }                                                 \
    if (ph == 8) { RUN((long)TOK * 2, it_select); }                                                                                      \
    if (ph == 9) { RUN_OFF((long)(TOK - ATT_TOK0) * 8 * LMAX, (long)ATT_TOK0 * 8 * LMAX, it_slc_score); }                                                                            \
    if (ph == 10) { RUN_OFF((long)(TOK - ATT_TOK0) * 8, (long)ATT_TOK0 * 8, it_slc_softmax); }                                                                                \
    if (ph == 11) { RUN_OFF((long)(TOK - ATT_TOK0) * 1024, (long)ATT_TOK0 * 1024, it_oslc); }                                                                                    \
    if (ph == 12) { RUN((long)TOK * 1024, it_combine); }                                                                                 \
    if (ph == 13) { RUN((long)TOK * D, it_o2); }                                                                                         \
    if (ph == 14) { RUN((long)TOK, it_rstd2); }                                                                                          \
    if (ph == 15) { RUN((long)TOK * D, it_y); }

#ifdef CPU_TEST
static void cpu_run_all(const Params& P) {
    for (int ph = 0; ph < N_PHASES; ++ph) {
#define RUN(n, fn) { const long _n = (n); _Pragma("omp parallel for schedule(static, 4096)") for (long _i = 0; _i < _n; ++_i) fn(P, _i); }
#define RUN_OFF(n, off, fn) { const long _n = (n), _o = (off); _Pragma("omp parallel for schedule(static, 4096)") for (long _i = 0; _i < _n; ++_i) fn(P, _i + _o); }
        PHASE_BODY(ph)
#undef RUN
#undef RUN_OFF
        fprintf(stderr, "phase %d done\n", ph);
    }
}
#else
#define LAS __attribute__((address_space(3)))
namespace pg8 {
#define PG8_LAS __attribute__((address_space(3)))
typedef unsigned short bf16_t;
typedef _Float16 bf16x8 __attribute__((ext_vector_type(8)));
typedef float f32x4 __attribute__((ext_vector_type(4)));
typedef unsigned u32x4 __attribute__((ext_vector_type(4)));
constexpr int BM = 256, BK = 64, HALF = 128, HTB = HALF * BK * 2  , STAGE_BYTES = 8 * HTB, NXCD = 8, WGM = 8;

__host__ __device__ __forceinline__ int lds_byte(int r, int c) { const int st = (r >> 4) * 2 + (c >> 5), rr = r & 15, cc = c & 31, ob = rr * 64 + cc * 2; return st * 1024 + (ob ^ (((ob >> 9) & 1) << 5)); }
__host__ __device__ __forceinline__ void stage_rc(int b, int& R, int& C) { const int st = b / 1024, sb = b % 1024, swz = sb ^ (((sb >> 9) & 1) << 5); R = (st >> 1) * 16 + swz / 64; C = (st & 1) * 32 + (swz % 64) / 2; }
__host__ __device__ __forceinline__ int perm32(int rho) { const int n = rho >> 4, i = rho & 15; return 8 * (i >> 2) + 4 * n + (i & 3); }

struct Unit { int pm, pn; };
struct Gemm { const bf16_t* A; const bf16_t* Bt; int M, N, K; };

struct StaticOrder {
    int nM, nN, nwg, G, c;
    __host__ __device__ void init(int M, int N, int G_, int c_) { nM = M / BM; nN = N / BM; nwg = nM * nN; G = G_; c = c_; }
    __host__ __device__ bool next(int i, Unit& u) const {
        const long L = (long)i * G + c; if (L >= nwg) return false;
        int wgid = (int)L; { const int q = nwg / NXCD, r = nwg % NXCD, xcd = wgid % NXCD, off = wgid / NXCD; wgid = (xcd < r ? xcd * (q + 1) : r * (q + 1) + (xcd - r) * q) + off; }
        const int nig = WGM * nN, gid = wgid / nig, fm = gid * WGM, gsz = (nM - fm) < WGM ? (nM - fm) : WGM;
        u.pm = fm + ((wgid % nig) % gsz); u.pn = (wgid % nig) / gsz; return true;
    }
    __device__ __forceinline__ void a_ready(const Unit&) const {}
    __device__ __forceinline__ void done(const Unit&) const {}
};
template <class Epi, class Sched, bool ALIGN_EPI = false, bool SP2 = false>
__device__ __forceinline__ void gemm_phase(PG8_LAS unsigned char* lds, const Gemm g, const Sched& S, const Epi& E) {
    int tid = threadIdx.x; asm volatile("" : "+v"(tid));
    const int wid = __builtin_amdgcn_readfirstlane(tid >> 6), lane = tid & 63, wr = wid >> 2, wc = wid & 3, fr = lane & 15, fq = lane >> 4;
    const int K = g.K, nt = K / BK;
    unsigned voffA[2], voffB[2];
#pragma unroll
    for (int i = 0; i < 2; ++i) { int R, C; stage_rc(tid * 16 + i * 8192, R, C); const int Rb = Epi::PERM ? ((R & ~31) + perm32(R & 31)) : R;
        voffA[i] = (unsigned)(R * K + C) * 2u; voffB[i] = (unsigned)(Rb * K + C) * 2u; }
    const size_t kstep = (size_t)(BK * 2);
    const size_t hstep = (size_t)HALF * K * 2;
    const size_t tstep = 2 * hstep;
    const unsigned ldsw = (unsigned)wid * 1024u;
    const int aoff = lds_byte(wr * 64 + fr, fq * 8), boff = lds_byte(wc * 32 + fr, fq * 8);
#define PG8_SA(b, h) (((b) * 2 + (h)) * HTB)
#define PG8_SB(b, h) ((4 + (b) * 2 + (h)) * HTB)
#define PG8_STAGE(bufoff, gbase, voff) do { _Pragma("unroll") for (int _i = 0; _i < 2; ++_i) \
        __builtin_amdgcn_global_load_lds((const unsigned*)((const char*)(gbase) + (voff)[_i]), (PG8_LAS unsigned*)(lds + (bufoff) + ldsw + _i * 8192), 16, 0, 0); } while (0)
#define PG8_LDA(dst, b, h) do { _Pragma("unroll") for (int m = 0; m < 4; ++m) _Pragma("unroll") for (int k = 0; k < 2; ++k) dst[m][k] = *(const PG8_LAS bf16x8*)(lds + PG8_SA(b, h) + aoff + m * 2048 + k * 1024); } while (0)
#define PG8_LDB(dst, b, h) do { _Pragma("unroll") for (int n = 0; n < 2; ++n) _Pragma("unroll") for (int k = 0; k < 2; ++k) dst[n][k] = *(const PG8_LAS bf16x8*)(lds + PG8_SB(b, h) + boff + n * 2048 + k * 1024); } while (0)
#define PG8_MMA(ai, bj, At, Bt) do { __builtin_amdgcn_s_setprio(1); _Pragma("unroll") for (int m = 0; m < 4; ++m) _Pragma("unroll") for (int n = 0; n < 2; ++n) _Pragma("unroll") for (int k = 0; k < 2; ++k) \
        acc[ai][bj][m][n] = __builtin_amdgcn_mfma_f32_16x16x32_f16(Bt[n][k], At[m][k], acc[ai][bj][m][n], 0, 0, 0); __builtin_amdgcn_s_setprio(0); } while (0)
#define PG8_WAIT_V(n) asm volatile("s_waitcnt vmcnt(" #n ")" ::: "memory")
#define PG8_WAIT_L(n) asm volatile("s_waitcnt lgkmcnt(" #n ")" ::: "memory")
#define PG8_BAR __builtin_amdgcn_s_barrier()
#define PG8_SCHED __builtin_amdgcn_sched_barrier(0)
    Unit cur, nxt; int ui = 0;
    if (!S.next(0, cur)) return;
    f32x4 acc[2][2][4][2];
#pragma unroll
    for (int a = 0; a < 2; ++a)
#pragma unroll
        for (int b = 0; b < 2; ++b)
#pragma unroll
            for (int m = 0; m < 4; ++m)
#pragma unroll
                for (int n = 0; n < 2; ++n) acc[a][b][m][n] = (f32x4){0.f, 0.f, 0.f, 0.f};
    bf16x8 At[4][2], B0[2][2], B1[2][2];
    const char* cA = (const char*)g.A + (size_t)cur.pm * tstep; const char* cB = (const char*)g.Bt + (size_t)cur.pn * tstep;
    S.a_ready(cur);
    if constexpr (SP2) {
        PG8_STAGE(PG8_SB(0, 0), cB, voffB); PG8_STAGE(PG8_SB(0, 1), cB + hstep, voffB); PG8_STAGE(PG8_SA(0, 0), cA, voffA); PG8_STAGE(PG8_SA(0, 1), cA + hstep, voffA);
        if (wr == 1) PG8_BAR;
        PG8_WAIT_V(2); PG8_BAR;
        PG8_STAGE(PG8_SB(1, 0), cB + kstep, voffB); PG8_STAGE(PG8_SA(1, 0), cA + kstep, voffA); PG8_STAGE(PG8_SB(1, 1), cB + hstep + kstep, voffB);
        PG8_WAIT_V(6); PG8_BAR;
    } else {
        PG8_STAGE(PG8_SB(0, 0), cB, voffB); PG8_STAGE(PG8_SA(0, 0), cA, voffA); PG8_STAGE(PG8_SB(0, 1), cB + hstep, voffB); PG8_STAGE(PG8_SA(0, 1), cA + hstep, voffA);
        if (wr == 1) PG8_BAR;
        PG8_WAIT_V(4); PG8_BAR;
        PG8_STAGE(PG8_SB(1, 0), cB + kstep, voffB); PG8_STAGE(PG8_SA(1, 0), cA + kstep, voffA); PG8_STAGE(PG8_SB(1, 1), cB + hstep + kstep, voffB);
        PG8_WAIT_V(6); PG8_BAR;
    }
    for (;;) {
        const bool has_next = S.next(ui + 1, nxt);
        const char* nA = has_next ? (const char*)g.A + (size_t)nxt.pm * tstep : cA; const char* nB = has_next ? (const char*)g.Bt + (size_t)nxt.pn * tstep : cB;
        for (int t = 0; t < nt; t += 2) {
            const bool last = (t == nt - 2);
            const char* a1 = cA + (size_t)(t + 1) * kstep;
            const char* a2 = last ? nA : cA + (size_t)(t + 2) * kstep; const char* b2 = last ? nB : cB + (size_t)(t + 2) * kstep;
            const char* a3 = a2 + kstep; const char* b3 = b2 + kstep;
            if (last && has_next) S.a_ready(nxt);
            if constexpr (SP2) {
            PG8_LDB(B0, 0, 0); PG8_LDB(B1, 0, 1); PG8_SCHED; PG8_LDA(At, 0, 0); PG8_STAGE(PG8_SA(1, 1), a1 + hstep, voffA);
            PG8_WAIT_V(8); PG8_WAIT_L(0); PG8_BAR; PG8_MMA(0, 0, At, B0); PG8_MMA(0, 1, At, B1); PG8_BAR; PG8_SCHED;
            PG8_LDA(At, 0, 1); PG8_STAGE(PG8_SB(0, 0), b2, voffB); PG8_STAGE(PG8_SB(0, 1), b2 + hstep, voffB); PG8_STAGE(PG8_SA(0, 0), a2, voffA);
            PG8_WAIT_V(8); PG8_WAIT_L(0); PG8_BAR; PG8_MMA(1, 0, At, B0); PG8_MMA(1, 1, At, B1); PG8_BAR; PG8_SCHED;
            PG8_LDB(B0, 1, 0); PG8_LDB(B1, 1, 1); PG8_SCHED; PG8_LDA(At, 1, 0); PG8_STAGE(PG8_SA(0, 1), a2 + hstep, voffA);
            PG8_WAIT_V(8); PG8_WAIT_L(0); PG8_BAR; PG8_MMA(0, 0, At, B0); PG8_MMA(0, 1, At, B1); PG8_BAR; PG8_SCHED;
            PG8_LDA(At, 1, 1); PG8_STAGE(PG8_SB(1, 0), b3, voffB); PG8_STAGE(PG8_SB(1, 1), b3 + hstep, voffB); PG8_STAGE(PG8_SA(1, 0), a3, voffA);
            PG8_WAIT_V(8); PG8_WAIT_L(0); PG8_BAR; PG8_MMA(1, 0, At, B0); PG8_MMA(1, 1, At, B1); PG8_BAR; PG8_SCHED;
            } else {
            PG8_LDB(B0, 0, 0); PG8_SCHED; PG8_LDA(At, 0, 0); PG8_STAGE(PG8_SA(1, 1), a1 + hstep, voffA);
            PG8_WAIT_L(8); PG8_BAR; PG8_WAIT_L(0); PG8_MMA(0, 0, At, B0); PG8_BAR; PG8_SCHED;
            PG8_LDB(B1, 0, 1); PG8_STAGE(PG8_SB(0, 0), b2, voffB);
            PG8_BAR; PG8_WAIT_L(0); PG8_MMA(0, 1, At, B1); PG8_BAR;
            PG8_LDA(At, 0, 1); PG8_STAGE(PG8_SA(0, 0), a2, voffA);
            PG8_BAR; PG8_WAIT_L(0); PG8_MMA(1, 0, At, B0); PG8_BAR; PG8_SCHED;
            PG8_STAGE(PG8_SB(0, 1), b2 + hstep, voffB);
            PG8_WAIT_V(6); PG8_BAR; PG8_MMA(1, 1, At, B1); PG8_BAR;
            PG8_LDB(B0, 1, 0); PG8_SCHED; PG8_LDA(At, 1, 0); PG8_STAGE(PG8_SA(0, 1), a2 + hstep, voffA);
            PG8_WAIT_L(8); PG8_BAR; PG8_WAIT_L(0); PG8_MMA(0, 0, At, B0); PG8_BAR; PG8_SCHED;
            PG8_LDB(B1, 1, 1); PG8_STAGE(PG8_SB(1, 0), b3, voffB);
            PG8_BAR; PG8_WAIT_L(0); PG8_MMA(0, 1, At, B1); PG8_BAR;
            PG8_LDA(At, 1, 1); PG8_STAGE(PG8_SA(1, 0), a3, voffA);
            PG8_BAR; PG8_WAIT_L(0); PG8_MMA(1, 0, At, B0); PG8_BAR; PG8_SCHED;
            PG8_STAGE(PG8_SB(1, 1), b3 + hstep, voffB);
            PG8_WAIT_V(6); PG8_BAR; PG8_MMA(1, 1, At, B1); PG8_BAR;
            }
        }
        if constexpr (ALIGN_EPI) { if (wr == 0) PG8_BAR; }
        if constexpr (!Epi::AFTER_DRAIN) { E(acc, cur, wr, wc, fr, fq); S.done(cur); }
        if (!has_next) break;
#pragma unroll
        for (int a = 0; a < 2; ++a)
#pragma unroll
            for (int b = 0; b < 2; ++b)
#pragma unroll
                for (int m = 0; m < 4; ++m)
#pragma unroll
                    for (int n = 0; n < 2; ++n) acc[a][b][m][n] = (f32x4){0.f, 0.f, 0.f, 0.f};
        cur = nxt; cA = nA; cB = nB; ++ui;
        if constexpr (ALIGN_EPI) { if (wr == 1) PG8_BAR; }
    }
    PG8_WAIT_V(0);
    if constexpr (!ALIGN_EPI) { if (wr == 0) PG8_BAR; }
    PG8_BAR;
    if constexpr (Epi::AFTER_DRAIN) { E.fused(acc, cur, wr, wc, fr, fq, lds, wid, lane); S.done(cur); }
#undef PG8_SA
#undef PG8_SB
#undef PG8_STAGE
#undef PG8_LDA
#undef PG8_LDB
#undef PG8_MMA
#undef PG8_WAIT_V
#undef PG8_WAIT_L
#undef PG8_BAR
#undef PG8_SCHED
}
}

namespace pg8 {
struct OneUnit {
    int pm, pn;
    __device__ __forceinline__ bool next(int i, Unit& u) const { if (i) return false; u.pm = pm; u.pn = pn; return true; }
    __device__ __forceinline__ void a_ready(const Unit&) const {}
    __device__ __forceinline__ void done(const Unit&) const {}
};
struct EpiF32 {
    static constexpr bool PERM = false, AFTER_DRAIN = false;
    float* C; int ldc;
    __device__ __forceinline__ void operator()(const f32x4 (&acc)[2][2][4][2], const Unit& u, int wr, int wc, int fr, int fq) const {
        const int row0 = u.pm * BM + wr * 64 + fr, col0 = u.pn * BM + wc * 32 + 4 * fq;
#pragma unroll
        for (int ai = 0; ai < 2; ++ai)
#pragma unroll
            for (int m = 0; m < 4; ++m) { float* rowp = C + (size_t)(row0 + ai * HALF + m * 16) * ldc + col0;
#pragma unroll
                for (int bj = 0; bj < 2; ++bj)
#pragma unroll
                    for (int n = 0; n < 2; ++n) *(f32x4*)(rowp + bj * HALF + n * 16) = acc[ai][bj][m][n]; }
    }
};

struct EpiProj {
    static constexpr bool PERM = false, AFTER_DRAIN = false;
    float* ws; float* out;
    static __device__ __forceinline__ unsigned pk(float lo, float hi) { typedef _Float16 h2v __attribute__((ext_vector_type(2))); h2v p; p.x = (_Float16)lo; p.y = (_Float16)hi; return __builtin_bit_cast(unsigned, p); }
    static __device__ __forceinline__ float silu(float x) { return x / (1.0f + __expf(-x)); }
    static __device__ __forceinline__ float sigm(float x) { return 1.0f / (1.0f + __expf(-x)); }
    __device__ __forceinline__ void operator()(const f32x4 (&acc)[2][2][4][2], const Unit& u, int wr, int wc, int fr, int fq) const {
        typedef unsigned u32x2v __attribute__((ext_vector_type(2)));
        const int pn = u.pn, rowb = u.pm * BM + wr * 64 + fr, colb = wc * 32 + 4 * fq;
        const bool samp = u.pm >= TOK_P / BM;
        if (samp) {
#pragma unroll
            for (int ai = 0; ai < 2; ++ai)
#pragma unroll
                for (int m = 0; m < 4; ++m) { float* rowp = ws + W_PROJ + (size_t)(rowb + ai * HALF + m * 16) * LDP + pn * BM + colb;
#pragma unroll
                    for (int bj = 0; bj < 2; ++bj)
#pragma unroll
                        for (int n = 0; n < 2; ++n) *(f32x4*)(rowp + bj * HALF + n * 16) = acc[ai][bj][m][n]; }
        }
#pragma unroll
        for (int ai = 0; ai < 2; ++ai)
#pragma unroll
            for (int m = 0; m < 4; ++m) {
                const int row = rowb + ai * HALF + m * 16;
                if (pn < 4) {
                    if (!samp) { _Float16* o = (_Float16*)(ws + W_Q16) + (size_t)row * 1024 + pn * BM + colb;
#pragma unroll
                        for (int bj = 0; bj < 2; ++bj)
#pragma unroll
                            for (int n = 0; n < 2; ++n) { const f32x4 v = acc[ai][bj][m][n]; u32x2v w; w.x = pk(v.x, v.y); w.y = pk(v.z, v.w); *(u32x2v*)(o + bj * HALF + n * 16) = w; } }
                } else if (pn < 8) {
                    const int c0 = (pn - 4) * BM + colb;
                    float* of = out + (samp ? O_KVS + (size_t)(row - TOK_P) * 1024 : O_KVP + (size_t)row * 1024) + c0;
#pragma unroll
                    for (int bj = 0; bj < 2; ++bj)
#pragma unroll
                        for (int n = 0; n < 2; ++n) { const f32x4 v = acc[ai][bj][m][n]; *(f32x4*)(of + bj * HALF + n * 16) = v;
                            if (!samp) { u32x2v w; w.x = pk(v.x, v.y); w.y = pk(v.z, v.w); *(u32x2v*)((_Float16*)(ws + W_KVW16) + (size_t)row * 1536 + c0 + bj * HALF + n * 16) = w; } }
                } else if (pn < 10) {
                    const int c0 = (pn - 8) * BM + colb;
                    float* of = nullptr;
                    if (samp) { const int r = row - TOK_P, b = r / DEC_SEQ, t = r % DEC_SEQ; of = out + O_WS + ((size_t)b * KEEP_S + (KEEP_S - DEC_SEQ) + t) * 512 + c0; }
                    else { const int b = row / SEQ, t = row % SEQ; if (t >= SEQ - KEEP_P) of = out + O_WP + ((size_t)b * KEEP_P + (t - (SEQ - KEEP_P))) * 512 + c0; }
#pragma unroll
                    for (int bj = 0; bj < 2; ++bj)
#pragma unroll
                        for (int n = 0; n < 2; ++n) { const f32x4 v = acc[ai][bj][m][n]; if (of) *(f32x4*)(of + bj * HALF + n * 16) = v;
                            if (!samp) { u32x2v w; w.x = pk(v.x, v.y); w.y = pk(v.z, v.w); *(u32x2v*)((_Float16*)(ws + W_KVW16) + (size_t)row * 1536 + 1024 + c0 + bj * HALF + n * 16) = w; } }
                } else if (pn == 10) {
                    if (wc == 0) {
#pragma unroll
                        for (int n = 0; n < 2; ++n) { const int c0 = 16 * n + 4 * fq; if (c0 < 24) { const f32x4 v = acc[ai][0][m][n]; *(f32x4*)(ws + W_GATES + (size_t)row * 32 + c0) = (f32x4){sigm(v.x), sigm(v.y), sigm(v.z), sigm(v.w)}; } } }
                } else if (pn < 15 || pn >= 23) {
                    _Float16* o = (_Float16*)(ws + (pn < 15 ? W_ZN16 : W_ZC16)) + (size_t)row * 1024 + (pn < 15 ? pn - 11 : pn - 23) * BM + colb;
#pragma unroll
                    for (int bj = 0; bj < 2; ++bj)
#pragma unroll
                        for (int n = 0; n < 2; ++n) { const f32x4 v = acc[ai][bj][m][n]; u32x2v w; w.x = pk(silu(v.x), silu(v.y)); w.y = pk(silu(v.z), silu(v.w)); *(u32x2v*)(o + bj * HALF + n * 16) = w; }
                } else {
                    float* o = ws + W_U + (size_t)row * 1024 + (pn - 15) * HALF + colb;
#pragma unroll
                    for (int n = 0; n < 2; ++n) { const f32x4 a = acc[ai][0][m][n], gl = acc[ai][1][m][n];
                        *(f32x4*)(o + n * 16) = (f32x4){a.x * sigm(gl.x), a.y * sigm(gl.y), a.z * sigm(gl.z), a.w * sigm(gl.w)}; }
                }
            }
    }
};
}

namespace fa {
typedef _Float16 h8 __attribute__((ext_vector_type(8)));
typedef _Float16 h4 __attribute__((ext_vector_type(4)));
typedef float f32x16 __attribute__((ext_vector_type(16)));
typedef float f32x4 __attribute__((ext_vector_type(4)));
typedef unsigned u32x4 __attribute__((ext_vector_type(4)));
constexpr int NW = 8, QBLK = 32, KVBLK = 64, QB = NW * QBLK, HD_ = 128;
constexpr int SHM_V = KVBLK * HD_ * 2, SHM_K = KVBLK * HD_ * 2;
constexpr int LDS_NEED = 2 * SHM_V + 2 * SHM_K + NW * 64 * 4;
constexpr int LDQ = 1024, LDK = 1536, LDO = 1024;
constexpr float SCALE = 0.08838834764831845f, THR = 8.f;

#define KSWZ(row, colB) ((row) * 256 + ((colB) ^ (((row) & 7) << 4)))
#define SBAR() __builtin_amdgcn_sched_barrier(0)
__device__ __forceinline__ int v_st(int k, int c) { const int kk = (k & ~0xC) | ((k & 4) << 1) | ((k & 8) >> 1); return ((kk >> 3) * 4 + (c >> 5)) * 512 + ((kk & 7) * 32 + (c & 31)) * 2; }
__device__ __forceinline__ int v_rd_base(int lane) { return ((lane & 3) << 3) | (((lane >> 2) & 3) << 6) | (((lane >> 4) & 1) << 5) | (((lane >> 5) & 1) << 8); }
constexpr int v_rd_off(int d0, int ks, int half) { return d0 * 512 + ks * 4096 + half * 2048; }
__device__ __forceinline__ int crow(int r, int hi) { return (r & 3) + 8 * (r >> 2) + 4 * hi; }
__device__ __forceinline__ unsigned cvtpk(float lo, float hi) { typedef _Float16 h2v __attribute__((ext_vector_type(2))); h2v p; p.x = (_Float16)lo; p.y = (_Float16)hi; return __builtin_bit_cast(unsigned, p); }
__device__ __forceinline__ h8 load8(const _Float16* p) { return *reinterpret_cast<const h8*>(p); }
__device__ __forceinline__ void mask_tile(f32x16& p0, f32x16& p1, int dq, unsigned W) {
    const float NEG = -__builtin_inff();
#pragma unroll
    for (int r = 0; r < 16; ++r) {
        const int c = (r & 3) + 8 * (r >> 2);
        if ((unsigned)(dq - c) >= W) p0[r] = NEG;
        if ((unsigned)(dq - c - 32) >= W) p1[r] = NEG;
    }
}
__device__ __forceinline__ void partialSM(f32x16& p0, f32x16& p1, float& m_reg, float& mn, float& alpha) {
    float pmax = p0[0]; for (int r = 1; r < 16; ++r) pmax = fmaxf(pmax, p0[r]); for (int r = 0; r < 16; ++r) pmax = fmaxf(pmax, p1[r]);
    { auto rr = __builtin_amdgcn_permlane32_swap(__float_as_uint(pmax), __float_as_uint(pmax), false, false);
      pmax = fmaxf(__uint_as_float(rr[0]), __uint_as_float(rr[1])); }
    constexpr float C2 = 1.4426950408889634f * SCALE;
    if (__builtin_expect(__all((pmax - m_reg) * SCALE <= THR), 1)) { mn = m_reg; alpha = 1.f; }
    else { mn = fmaxf(m_reg, pmax); alpha = __builtin_amdgcn_exp2f((m_reg - mn) * C2); m_reg = mn; }
    const float mnL = -mn * C2;
    for (int r = 0; r < 16; ++r) p0[r] = fmaf(p0[r], C2, mnL); for (int r = 0; r < 16; ++r) p1[r] = fmaf(p1[r], C2, mnL);
    for (int r = 0; r < 16; ++r) p0[r] = __builtin_amdgcn_exp2f(p0[r]);
}
__device__ __forceinline__ void finishSM(f32x16& p0, f32x16& p1, float alpha, float& l_reg, h8& pa0, h8& pa1, h8& pa2, h8& pa3) {
    for (int r = 0; r < 16; ++r) p1[r] = __builtin_amdgcn_exp2f(p1[r]);
    float ps = 0; for (int r = 0; r < 16; ++r) ps += p0[r]; for (int r = 0; r < 16; ++r) ps += p1[r];
    { auto rr = __builtin_amdgcn_permlane32_swap(__float_as_uint(ps), __float_as_uint(ps), false, false);
      ps = __uint_as_float(rr[0]) + __uint_as_float(rr[1]); }
    l_reg = l_reg * alpha + ps;
#define PK4(P, B_, OUT) do { unsigned a0 = cvtpk(P[B_+0], P[B_+1]), a1 = cvtpk(P[B_+2], P[B_+3]);                          \
        unsigned b0 = cvtpk(P[B_+4], P[B_+5]), b1 = cvtpk(P[B_+6], P[B_+7]);                                             \
        auto r0 = __builtin_amdgcn_permlane32_swap(a0, b0, false, false); auto r1 = __builtin_amdgcn_permlane32_swap(a1, b1, false, false); \
        u32x4 w = {r0[0], r1[0], r0[1], r1[1]}; OUT = *reinterpret_cast<h8*>(&w); } while (0)
    PK4(p0, 0, pa0); PK4(p0, 8, pa1); PK4(p1, 0, pa2); PK4(p1, 8, pa3);
#undef PK4
}
template <int KB>
__device__ __forceinline__ void qkt(f32x16& p0, f32x16& p1, const char* K_lds, int r32, int hi, const h8* qr) {
    p0 = f32x16{}; p1 = f32x16{};
    const char* kb[4];
#pragma unroll
    for (int dd = 0; dd < 4; ++dd) kb[dd] = K_lds + KB * SHM_K + KSWZ(r32, (dd * 16 + hi * 8) * 2);
#pragma unroll
    for (int d0 = 0; d0 < 8; ++d0) { const char* a = kb[d0 & 3] + (d0 >> 2) * 128;
        h8 b0 = *reinterpret_cast<const h8*>(a);
        h8 b1 = *reinterpret_cast<const h8*>(a + 32 * 256);
        p0 = __builtin_amdgcn_mfma_f32_32x32x16_f16(b0, qr[d0], p0, 0, 0, 0);
        p1 = __builtin_amdgcn_mfma_f32_32x32x16_f16(b1, qr[d0], p1, 0, 0, 0); }
}
template <int VB>
__device__ __forceinline__ void pv_tile(f32x16* o, int vb0, h8 pa0, h8 pa1, h8 pa2, h8 pa3) {
#define TRRD(dst, off) asm volatile("ds_read_b64_tr_b16 %0, %1 offset:%2" : "=&v"(dst) : "v"(vb0), "i"(off) : "memory")
#define PV_D0(d0) do { h4 l0, l1, l2, l3, h0, h1, h2, h3; constexpr int b_ = VB * SHM_V + v_rd_off(d0, 0, 0);   \
        TRRD(l0, b_); TRRD(h0, b_ + 2048); TRRD(l1, b_ + 4096); TRRD(h1, b_ + 6144); TRRD(l2, b_ + 8192); TRRD(h2, b_ + 10240); TRRD(l3, b_ + 12288); TRRD(h3, b_ + 14336); \
        asm volatile("s_waitcnt lgkmcnt(0)" ::: "memory"); SBAR();   \
        o[d0] = __builtin_amdgcn_mfma_f32_32x32x16_f16(pa0, (h8){l0[0], l0[1], l0[2], l0[3], h0[0], h0[1], h0[2], h0[3]}, o[d0], 0, 0, 0);   \
        o[d0] = __builtin_amdgcn_mfma_f32_32x32x16_f16(pa1, (h8){l1[0], l1[1], l1[2], l1[3], h1[0], h1[1], h1[2], h1[3]}, o[d0], 0, 0, 0);   \
        o[d0] = __builtin_amdgcn_mfma_f32_32x32x16_f16(pa2, (h8){l2[0], l2[1], l2[2], l2[3], h2[0], h2[1], h2[2], h2[3]}, o[d0], 0, 0, 0);   \
        o[d0] = __builtin_amdgcn_mfma_f32_32x32x16_f16(pa3, (h8){l3[0], l3[1], l3[2], l3[3], h3[0], h3[1], h3[2], h3[3]}, o[d0], 0, 0, 0); } while (0)
    PV_D0(0); PV_D0(1); PV_D0(2); PV_D0(3);
#undef PV_D0
#undef TRRD
}
constexpr int SELSTRIDE = 4;
struct BlockRef { const _Float16* Q; const _Float16* K; const _Float16* V; float* O; const unsigned* sel; int P0; int W; };
struct Seam { h8 qr[8]; h8 st_v0, st_v1, st_k0, st_k1; };
__device__ __forceinline__ int swa_jlo(int P0, int W) { const int lowk = P0 - W + 1; return lowk > 0 ? lowk / KVBLK : 0; }
#define ROW(p, k0, rr) ((p) + (size_t)((k0) + (rr)) * LDK + sc)
#define VMW() asm volatile("s_waitcnt vmcnt(0)" ::: "memory")
#define VMWN(n) asm volatile("s_waitcnt vmcnt(%0)" :: "i"(n) : "memory")
#define SLOAD_H(Kp, Vp, k0) do { S.st_v0 = load8(ROW(Vp, k0, sr)); S.st_v1 = load8(ROW(Vp, k0, 32 + sr));              \
                         S.st_k0 = load8(ROW(Kp, k0, sr)); S.st_k1 = load8(ROW(Kp, k0, 32 + sr)); } while (0)
#define SWRITE_HK(bf) do { *(h8*)(K_lds + (bf) * SHM_K + kws) = S.st_k0; *(h8*)(K_lds + (bf) * SHM_K + kws + 32 * 256) = S.st_k1; } while (0)
#define SWRITE_HV(bf) do { *(h8*)(V_lds + (bf) * SHM_V + vst0) = S.st_v0; *(h8*)(V_lds + (bf) * SHM_V + vst0 + vst1_off) = S.st_v1; } while (0)
#define SWRITE_H(bf) do { SWRITE_HV(bf); SWRITE_HK(bf); } while (0)
__device__ __forceinline__ void swa_prime(const BlockRef& cur, char* lds, Seam& S) {
    const int tid = threadIdx.x, wid = __builtin_amdgcn_readfirstlane(tid >> 6), lane = tid & 63, r32 = lane & 31, hi = lane >> 5;
    const int sr = tid >> 4, sc = (tid & 15) * 8, kws = KSWZ(sr, sc * 2); char* K_lds = lds + 2 * SHM_V;
    const int kb0 = swa_jlo(cur.P0, cur.W) * KVBLK;
    for (int d0 = 0; d0 < 8; ++d0) S.qr[d0] = load8(cur.Q + (size_t)(wid * QBLK + r32) * LDQ + d0 * 16 + hi * 8);
    SLOAD_H(cur.K, cur.V, kb0); VMW(); SWRITE_HK(0);
    __syncthreads();
}
__device__ __forceinline__ void swa_block(const BlockRef& cur, const BlockRef& nxt, int skv, char* lds, Seam& S) {
    int tid = threadIdx.x; asm volatile("" : "+v"(tid));
    const int wid = __builtin_amdgcn_readfirstlane(tid >> 6), lane = tid & 63, r32 = lane & 31, hi = lane >> 5;
    const int W = cur.W;
    const int j_lo = swa_jlo(cur.P0, W);
    int j_hi = (cur.P0 + QB - 1) / KVBLK + 1; if (j_hi > skv / KVBLK) j_hi = skv / KVBLK;
    const int NT = j_hi - j_lo;
    const int kbn = swa_jlo(nxt.P0, nxt.W) * KVBLK;
    const int qlo = cur.P0 + wid * QBLK, qm = qlo + r32 - 4 * hi;
    char* V_lds = lds; char* K_lds = lds + 2 * SHM_V;
    float* ws = (float*)(lds + 2 * SHM_V + 2 * SHM_K) + wid * 64; float* li_l = ws, * al_l = ws + 32;
    float m_reg = -1e30f, l_reg = 0; f32x16 o[4] = {};
    const int sr = tid >> 4, sc = (tid & 15) * 8, vst0 = v_st(sr, sc), kws = KSWZ(sr, sc * 2); constexpr int vst1_off = 8192;
    const int vb0 = (int)(uintptr_t)V_lds + v_rd_base(lane);
    const _Float16* Kh = cur.K; const _Float16* Vh = cur.V;
    const unsigned selrow = cur.sel ? cur.sel[(size_t)(wid * QBLK + r32) * SELSTRIDE] : 0xffffffffu;
#define RESC(a) do { if (__any((a) < 1.f)) { if (hi == 0) al_l[r32] = (a); asm volatile("s_waitcnt lgkmcnt(0)" ::: "memory");              \
                     for (int d_ = 0; d_ < 4; ++d_) for (int r = 0; r < 16; ++r) o[d_][r] *= al_l[crow(r, hi)]; } } while (0)
#define KBASE(t) ((j_lo + (t)) * KVBLK)
#define MASKT(P0_, P1_, t) do { const int kb_ = KBASE(t); if (kb_ + KVBLK - 1 > qlo || kb_ <= qlo + QBLK - 1 - W) mask_tile(P0_, P1_, qm - kb_, (unsigned)W);   \
        { const bool ok_ = (selrow >> (j_lo + (t))) & 1u; if (!__all(ok_)) { const float NEG_ = -__builtin_inff(); if (!ok_) { for (int r = 0; r < 16; ++r) { P0_[r] = NEG_; P1_[r] = NEG_; } } } } } while (0)
    constexpr int NQL = 8;
#define SEAM_K0() do { VMWN(NQL); SWRITE_HK(0); SBAR(); } while (0)
    f32x16 pA0, pA1, pB0, pB1; float mnA, mnB, alA, alB; h8 pa0, pa1, pa2, pa3;
    SWRITE_HV(0); SBAR();
    if (NT > 1) { SLOAD_H(Kh, Vh, KBASE(1)); }
    SBAR(); qkt<0>(pA0, pA1, K_lds, r32, hi, S.qr);
    MASKT(pA0, pA1, 0); partialSM(pA0, pA1, m_reg, mnA, alA);
    if (NT > 1) { VMW(); SWRITE_H(1); }
    __syncthreads();
#define HALF_STEP(PX0, PX1, mnX, alX, PY0, PY1, alY, t, KB, VB, SB) do {                                                      \
        SBAR(); qkt<KB>(PX0, PX1, K_lds, r32, hi, S.qr);                                             \
        finishSM(PY0, PY1, alY, l_reg, pa0, pa1, pa2, pa3); SBAR();                                                           \
        if ((t) + 1 < NT) { SLOAD_H(Kh, Vh, KBASE((t) + 1)); SBAR(); }                                               \
        pv_tile<VB>(o, vb0, pa0, pa1, pa2, pa3); MASKT(PX0, PX1, (t)); partialSM(PX0, PX1, m_reg, mnX, alX);                                        \
        __syncthreads();                                                                                                      \
        if ((t) + 1 < NT) { VMW(); SWRITE_H(SB); }                                                                          \
        RESC(alX); __syncthreads(); } while (0)
    for (int t = 1; t + 1 < NT; t += 2) {
        HALF_STEP(pB0, pB1, mnB, alB, pA0, pA1, alA, t, 1, 0, 0);
        HALF_STEP(pA0, pA1, mnA, alA, pB0, pB1, alB, t + 1, 0, 1, 1);
    }
    const bool even = (NT & 1) == 0;
    if (even) { SBAR(); qkt<1>(pB0, pB1, K_lds, r32, hi, S.qr); SBAR(); }
    { SLOAD_H(nxt.K, nxt.V, kbn); SBAR();
#pragma unroll
        for (int d0 = 0; d0 < 8; ++d0) S.qr[d0] = load8(nxt.Q + (size_t)(wid * QBLK + r32) * LDQ + d0 * 16 + hi * 8); }
    SBAR();
    finishSM(pA0, pA1, alA, l_reg, pa0, pa1, pa2, pa3); SBAR();
    pv_tile<0>(o, vb0, pa0, pa1, pa2, pa3);
    if (even) { MASKT(pB0, pB1, NT - 1); partialSM(pB0, pB1, m_reg, mnB, alB); __syncthreads(); RESC(alB);
        finishSM(pB0, pB1, alB, l_reg, pa0, pa1, pa2, pa3); SBAR(); pv_tile<1>(o, vb0, pa0, pa1, pa2, pa3); }
    SBAR(); SEAM_K0();
    if (hi == 0) li_l[r32] = l_reg; asm volatile("s_waitcnt lgkmcnt(0)" ::: "memory");
    float rli[16];
#pragma unroll
    for (int r = 0; r < 16; ++r) rli[r] = __builtin_amdgcn_rcpf(li_l[crow(r, hi)]);
    float* Ow = cur.O + (size_t)(wid * QBLK) * LDO;
#pragma unroll
    for (int r = 0; r < 16; ++r) { const int orow = crow(r, hi);
#pragma unroll
        for (int d0 = 0; d0 < 4; ++d0) Ow[(size_t)orow * LDO + d0 * 32 + r32] = o[d0][r] * rli[r]; }
    __syncthreads();
#undef RESC
#undef KBASE
#undef MASKT
#undef SEAM_K0
#undef HALF_STEP
}
#undef ROW
#undef VMW
#undef VMWN
#undef SLOAD_H
#undef SWRITE_HK
#undef SWRITE_HV
#undef SWRITE_H
#undef KSWZ
#undef SBAR
}

namespace cmpb {
typedef _Float16 h8 __attribute__((ext_vector_type(8)));
typedef float f32x4 __attribute__((ext_vector_type(4)));
typedef unsigned u32x4 __attribute__((ext_vector_type(4)));
__device__ __forceinline__ h8 cvt8(f32x4 a, f32x4 b) {
    typedef _Float16 h2v __attribute__((ext_vector_type(2)));
    h2v p0, p1, p2, p3; p0.x = (_Float16)a.x; p0.y = (_Float16)a.y; p1.x = (_Float16)a.z; p1.y = (_Float16)a.w; p2.x = (_Float16)b.x; p2.y = (_Float16)b.y; p3.x = (_Float16)b.z; p3.y = (_Float16)b.w;
    u32x4 w = {__builtin_bit_cast(unsigned, p0), __builtin_bit_cast(unsigned, p1), __builtin_bit_cast(unsigned, p2), __builtin_bit_cast(unsigned, p3)};
    return __builtin_bit_cast(h8, w);
}
__device__ __forceinline__ void compress_unit(const Params& P, char* lds, int seq, int sg) {
    static_assert(NCMP_P == 127 && NCMP_S == 127 && PAGE == 128, "compress_unit is written for 2048 compressed-over positions");
    int tid = threadIdx.x; asm volatile("" : "+v"(tid));
    const int wave = __builtin_amdgcn_readfirstlane(tid >> 6), lane = tid & 63, r16 = lane & 15, kg = lane >> 4, s = sg >> 1;
    const int c = wave * 16 + r16;
    const float* abase; long astride;
    if (seq < BATCH) { abase = P.out + O_KVP + ((long)seq * SEQ + 16 * c) * 1024 + sg * 128 + 8 * kg; astride = 1024; }
    else { const int b = seq - BATCH; const int pg = P.ptab[b * NPAGES + (c >> 3)]; abase = P.cache + ((long)pg * PAGE + 16 * (c & 7)) * 1024 + sg * 128 + 8 * kg; astride = 1024; }
    const _Float16* wsrc = (const _Float16*)(P.ws + W_WC16) + (long)s * 256 * 2048;
    char* buf0 = lds; char* buf1 = lds + 32768;
    f32x4 acc[16];
#pragma unroll
    for (int i = 0; i < 16; ++i) acc[i] = (f32x4){0.f, 0.f, 0.f, 0.f};
    f32x4 a0[4], a1[4], a2[4], a3[4]; u32x4 bs0[4], bs1[4];
    const int nb = tid >> 3, chb = tid & 7;
    const unsigned voffB = (unsigned)((nb * 2048 + chb * 8) * 2);
    const int wrB = nb * 128 + ((chb ^ ((nb >> 1) & 7)) << 4);
    const int rdB = r16 * 128;
#define LOAD_A(dst, tt) do { const float* p_ = abase + (long)((tt) >> 1) * astride + 64 * ((tt) & 1); _Pragma("unroll") for (int ks = 0; ks < 2; ++ks) { dst[2 * ks] = __builtin_nontemporal_load((const f32x4*)(p_ + 32 * ks)); dst[2 * ks + 1] = __builtin_nontemporal_load((const f32x4*)(p_ + 32 * ks + 4)); } } while (0)
#define LOAD_B(bst, tt) do { _Pragma("unroll") for (int i = 0; i < 4; ++i) { const char* ub_ = (const char*)(wsrc + (long)i * 64 * 2048 + (tt) * 64); bst[i] = *(const u32x4*)(ub_ + voffB); } } while (0)
#define WRITE_B(buf, bst) do { _Pragma("unroll") for (int i = 0; i < 4; ++i) *(u32x4*)((buf) + wrB + i * 8192) = bst[i]; } while (0)
#define CSB() __builtin_amdgcn_sched_barrier(0)
#define COMPUTE(a, buf) do { _Pragma("unroll") for (int ks = 0; ks < 2; ++ks) { const h8 af = cvt8(a[2 * ks], a[2 * ks + 1]); const char* rb_ = (buf) + rdB + (((4 * ks + kg) ^ (r16 >> 1)) << 4);   \
        _Pragma("unroll") for (int hf = 0; hf < 2; ++hf) { h8 bf[8];                                                                                              \
            _Pragma("unroll") for (int j = 0; j < 8; ++j) bf[j] = *(const h8*)(rb_ + (8 * hf + j) * 2048);                                                        \
            _Pragma("unroll") for (int j = 0; j < 8; ++j) acc[8 * hf + j] = __builtin_amdgcn_mfma_f32_16x16x32_f16(af, bf[j], acc[8 * hf + j], 0, 0, 0);          \
            CSB(); } } } while (0)
#define STEP(t_, a_, bufc, bufn, bsn) do { __syncthreads();                                                             \
        if ((t_) + 1 < 32) WRITE_B(bufn, bsn);             \
        CSB(); if ((t_) + 3 < 32) LOAD_B(bsn, (t_) + 3);                                                                  \
        CSB(); COMPUTE(a_, bufc); CSB();                                                                                 \
        if ((t_) + 4 < 32) LOAD_A(a_, (t_) + 4);                                                                          \
        CSB(); } while (0)
    LOAD_A(a0, 0); LOAD_A(a1, 1); LOAD_A(a2, 2); LOAD_A(a3, 3); LOAD_B(bs0, 0); WRITE_B(buf0, bs0); LOAD_B(bs1, 1); LOAD_B(bs0, 2);
#pragma unroll
    for (int t = 0; t < 32; t += 4) {
        STEP(t, a0, buf0, buf1, bs1); STEP(t + 1, a1, buf1, buf0, bs0); STEP(t + 2, a2, buf0, buf1, bs1); STEP(t + 3, a3, buf1, buf0, bs0);
    }
#undef STEP
#undef LOAD_A
#undef LOAD_B
#undef WRITE_B
#undef COMPUTE
#undef CSB
    __syncthreads();
    float* ldsf = (float*)lds; char* R2 = lds + 67584;
#pragma unroll
    for (int nt = 8; nt < 16; ++nt)
#pragma unroll
        for (int i = 0; i < 4; ++i) ldsf[(wave * 16 + 4 * kg + i) * 132 + 16 * (nt - 8) + r16] = acc[nt][i];
    __syncthreads();
#pragma unroll
    for (int nt = 0; nt < 8; ++nt) { const int e = 16 * nt + r16; const float cst = P.ws[W_CCONST + s * 128 + e];
#pragma unroll
        for (int i = 0; i < 4; ++i) { const int cc = wave * 16 + 4 * kg + i; const float hb = cc < 127 ? ldsf[(cc + 1) * 132 + e] : 0.f;
            const float v = acc[nt][i] + hb + cst; const float hh = v / (1.0f + __expf(-v));
            *(_Float16*)(R2 + cc * 256 + (((e >> 3) ^ (cc & 15)) << 4) + (e & 7) * 2) = (_Float16)hh; } }
    __syncthreads();
    f32x4 acc2[8];
#pragma unroll
    for (int i = 0; i < 8; ++i) acc2[i] = (f32x4){0.f, 0.f, 0.f, 0.f};
    const _Float16* w2t = (const _Float16*)(P.ws + W_W2T16) + (long)s * 128 * 128;
#pragma unroll
    for (int ks = 0; ks < 4; ++ks) { const h8 af = *(const h8*)(R2 + c * 256 + (((4 * ks + kg) ^ (c & 15)) << 4));
#pragma unroll
        for (int nt = 0; nt < 8; ++nt) { const h8 bf = *(const h8*)(w2t + (16 * nt + r16) * 128 + 32 * ks + 8 * kg);
            acc2[nt] = __builtin_amdgcn_mfma_f32_16x16x32_f16(af, bf, acc2[nt], 0, 0, 0); } }
    float b2v[8];
#pragma unroll
    for (int nt = 0; nt < 8; ++nt) b2v[nt] = P.b2[s * 128 + 16 * nt + r16];
#pragma unroll
    for (int nt = 0; nt < 8; ++nt)
#pragma unroll
        for (int i = 0; i < 4; ++i) ldsf[(wave * 16 + 4 * kg + i) * 132 + 16 * nt + r16] = acc2[nt][i] + b2v[nt];
    __syncthreads();
#pragma unroll
    for (int it = 0; it < 8; ++it) { const int e = it * 512 + tid, n = e >> 5, c4 = e & 31;
        if (n < 127) *(f32x4*)(P.ws + W_KC + (((long)seq * NCMPX + n) * 4 + sg) * 128 + 4 * c4) = *(const f32x4*)(ldsf + n * 132 + 4 * c4); }
    __syncthreads();
}
}

namespace sam {
typedef float f32x4 __attribute__((ext_vector_type(4)));
constexpr float SC2 = 0.08838834764831845f * 1.4426950408889634f;
struct TileDesc { const float* kb; const float* vb; long stride; int nrows; };
struct Acc { float m, l; f32x4 o[2][4]; };
__device__ __forceinline__ void acc_init(Acc& A) { A.m = -1e30f; A.l = 0.f;
#pragma unroll
    for (int hf = 0; hf < 2; ++hf)
#pragma unroll
        for (int c = 0; c < 4; ++c) A.o[hf][c] = (f32x4){0.f, 0.f, 0.f, 0.f}; }
__device__ __forceinline__ void load_k(f32x4 (&kr)[8], const TileDesc& d, int row0, int lane) {
    const int key = lane & 15, kk = lane >> 4;
    int rk = row0 + key; rk = rk < d.nrows ? rk : d.nrows - 1;
    const float* kp = d.kb + (long)rk * d.stride + 8 * kk;
#pragma unroll
    for (int u = 0; u < 4; ++u) { kr[2 * u] = __builtin_nontemporal_load((const f32x4*)(kp + 32 * u)); kr[2 * u + 1] = __builtin_nontemporal_load((const f32x4*)(kp + 32 * u + 4)); }
}
__device__ __forceinline__ void load_v(f32x4 (&vr)[8], const TileDesc& d, int row0, int lane) {
    const int key = lane & 15, kk = lane >> 4;
#pragma unroll
    for (int i = 0; i < 4; ++i) { int rv = row0 + 4 * kk + i; rv = rv < d.nrows ? rv : d.nrows - 1; const float* vp = d.vb + (long)rv * d.stride + 4 * key;
        vr[2 * i] = __builtin_nontemporal_load((const f32x4*)vp); vr[2 * i + 1] = __builtin_nontemporal_load((const f32x4*)(vp + 64)); }
}
__device__ __forceinline__ f32x4 tile_qk(const f32x4 (&kr)[8], const float* ql, int row0, bool okblk, int lo, int hi, int nrows, int lane) {
    f32x4 s0 = (f32x4){0.f, 0.f, 0.f, 0.f}, s1 = (f32x4){0.f, 0.f, 0.f, 0.f};
#pragma unroll
    for (int u = 0; u < 4; ++u) { const f32x4 qa = *(const f32x4*)(ql + 32 * u), qb = *(const f32x4*)(ql + 32 * u + 4);
#pragma unroll
        for (int c = 0; c < 4; ++c) { s0 = __builtin_amdgcn_mfma_f32_16x16x4f32(kr[2 * u][c], qa[c], s0, 0, 0, 0); s1 = __builtin_amdgcn_mfma_f32_16x16x4f32(kr[2 * u + 1][c], qb[c], s1, 0, 0, 0); } }
    f32x4 s = s0 + s1;
    const int grp = lane >> 4; const float NEG = -__builtin_inff();
#pragma unroll
    for (int i = 0; i < 4; ++i) { const int row = row0 + 4 * grp + i; const bool ok = okblk && row >= lo && row <= hi && row < nrows; s[i] = ok ? s[i] : NEG; }
    return s;
}
__device__ __forceinline__ void tile_pv(const f32x4 s, const f32x4 (&vr)[8], Acc& A, int lane) {
    float mx = fmaxf(fmaxf(s[0], s[1]), fmaxf(s[2], s[3])); mx = fmaxf(mx, __shfl_xor(mx, 16)); mx = fmaxf(mx, __shfl_xor(mx, 32));
    const float mn = fmaxf(A.m, mx), alpha = __builtin_amdgcn_exp2f((A.m - mn) * SC2);
    f32x4 p;
#pragma unroll
    for (int i = 0; i < 4; ++i) p[i] = __builtin_amdgcn_exp2f((s[i] - mn) * SC2);
    float ps = (p[0] + p[1]) + (p[2] + p[3]); ps += __shfl_xor(ps, 16); ps += __shfl_xor(ps, 32);
    A.l = A.l * alpha + ps; A.m = mn;
    if (__any(alpha < 1.f)) {
#pragma unroll
        for (int r = 0; r < 4; ++r) { const float ar = __shfl(alpha, 4 * (lane >> 4) + r);
#pragma unroll
            for (int hf = 0; hf < 2; ++hf)
#pragma unroll
                for (int c = 0; c < 4; ++c) A.o[hf][c][r] *= ar; } }
#pragma unroll
    for (int i = 0; i < 4; ++i)
#pragma unroll
        for (int hf = 0; hf < 2; ++hf)
#pragma unroll
            for (int c = 0; c < 4; ++c) A.o[hf][c] = __builtin_amdgcn_mfma_f32_16x16x4f32(p[i], vr[2 * i + hf][c], A.o[hf][c], 0, 0, 0);
}
constexpr int L_PO = 0, L_PM = 65536, L_PL = 65536 + 512, L_OC = 66560, L_PSUM = 74752, L_SC = 76800, L_SELW = 77440, L_PAGES = 77504, L_SRAW = 77568, L_OW = 77568 + 8 * 64 * 16, L_QL = L_OW + 512 * 16, QL_LD = 132, L_END = L_QL + 16 * QL_LD * 4;
__device__ __forceinline__ TileDesc make_desc(const Params& P, const int* pages, int mode, int blk, int b, int g) {
    TileDesc d; const long tok0 = TOK_P + 4L * b; const int seq = BATCH + b;
    if (mode == 0) { d.kb = P.ws + W_KC + (((long)seq * NCMPX + 64 * blk) * 4 + g) * 128; d.vb = d.kb + 256; d.stride = 512; d.nrows = blk == 0 ? 64 : NCMP_S - 64; }
    else if (mode == 1) {
        if (blk < PAST / 64) { const int pg = pages[blk >> 1]; d.kb = P.cache + ((long)pg * PAGE + (blk & 1) * 64) * 1024 + (4 + g) * 128; d.vb = d.kb + 256; d.stride = 1024; d.nrows = 64; }
        else { d.kb = P.ws + W_PROJ + tok0 * LDP + C_KV + (4 + g) * 128; d.vb = d.kb + 256; d.stride = LDP; d.nrows = DEC_SEQ; } }
    else {
        if (blk < PW / 64) { d.kb = P.swin + ((long)b * PW + 64 * blk) * 512 + g * 128; d.vb = d.kb + 256; d.stride = 512; d.nrows = 64; }
        else { d.kb = P.ws + W_PROJ + tok0 * LDP + C_WIN + g * 128; d.vb = d.kb + 256; d.stride = LDP; d.nrows = DEC_SEQ; } }
    return d;
}
template <bool SRAW>
__device__ __forceinline__ void run_blocks(const Params& P, const int* pages, int mode, unsigned blist, int nb, int b, int g, const float* q, Acc& A, int lane, unsigned selw_lo, unsigned selw_hi, f32x4* sraw_lds) {
    const int t = (lane & 15) >> 2; const int ntile = 4 * nb;
    f32x4 kA[8], kB[8], vA[8], vB[8];
#define DESC(ti) make_desc(P, pages, mode, (int)((blist >> (6 * ((ti) >> 2))) & 63u), b, g)
#define MASKP(ti, okv, lov, hiv) do { const int blk_ = (int)((blist >> (6 * ((ti) >> 2))) & 63u); okv = true; lov = 0; hiv = 63;                                            \
        if (mode == 1) { okv = blk_ < 32 ? ((selw_lo >> blk_) & 1u) : ((selw_hi >> (blk_ - 32)) & 1u); if (blk_ >= PAST / 64) hiv = t; }                                   \
        if (mode == 2) { if (blk_ < PW / 64) lov = t - 64 * blk_; else hiv = t; } } while (0)
#define LOADK(kr, ti) do { const TileDesc d_ = DESC(ti); load_k(kr, d_, 16 * ((ti) & 3), lane); } while (0)
#define LOADV(vr_, ti) do { const TileDesc d_ = DESC(ti); load_v(vr_, d_, 16 * ((ti) & 3), lane); } while (0)
#define STEPT(kcur, vcur, knext, vnext, ti) do { if ((ti) + 1 < ntile) { LOADK(knext, (ti) + 1); LOADV(vnext, (ti) + 1); }                          \
        __builtin_amdgcn_sched_barrier(0);                                                                                                         \
        const TileDesc d_ = DESC(ti); bool ok_; int lo_, hi_; MASKP(ti, ok_, lo_, hi_);                                                            \
        const f32x4 sc_ = tile_qk(kcur, q, 16 * ((ti) & 3), ok_, lo_, hi_, d_.nrows, lane); if (SRAW) sraw_lds[(ti) * 64 + lane] = sc_;            \
        tile_pv(sc_, vcur, A, lane);                                                                                                               \
        __builtin_amdgcn_sched_barrier(0); } while (0)
    if (ntile > 0) { LOADK(kA, 0); LOADV(vA, 0); }
    for (int ti = 0; ti < ntile; ti += 2) {
        STEPT(kA, vA, kB, vB, ti);
        if (ti + 1 < ntile) STEPT(kB, vB, kA, vA, ti + 1);
    }
#undef LOADK
#undef LOADV
#undef STEPT
#undef DESC
#undef MASKP
}
__device__ __forceinline__ void write_partial(char* lds, const Acc& A, int wave, int lane) {
    const int j = lane & 15, rg = lane >> 4;
#pragma unroll
    for (int hf = 0; hf < 2; ++hf)
#pragma unroll
        for (int r = 0; r < 4; ++r) *(f32x4*)(lds + L_PO + wave * 8192 + ((4 * rg + r) * 128 + 64 * hf + 4 * j) * 4) = (f32x4){A.o[hf][0][r], A.o[hf][1][r], A.o[hf][2][r], A.o[hf][3][r]};
    if (lane < 16) { ((float*)(lds + L_PM))[wave * 16 + lane] = A.m; ((float*)(lds + L_PL))[wave * 16 + lane] = A.l; }
}
__device__ __forceinline__ f32x4 combine_partials(const char* lds, int tid) {
    const int qrow = tid >> 5, d4 = tid & 31; const float* pm = (const float*)(lds + L_PM); const float* pl = (const float*)(lds + L_PL);
    float M = pm[qrow];
#pragma unroll
    for (int w = 1; w < 8; ++w) M = fmaxf(M, pm[w * 16 + qrow]);
    float L = 0.f; f32x4 o = (f32x4){0.f, 0.f, 0.f, 0.f};
#pragma unroll
    for (int w = 0; w < 8; ++w) { const float e = __builtin_amdgcn_exp2f((pm[w * 16 + qrow] - M) * SC2); L += pl[w * 16 + qrow] * e; o += *(const f32x4*)(lds + L_PO + w * 8192 + (qrow * 128 + 4 * d4) * 4) * e; }
    return o * (1.0f / L);
}
__device__ __forceinline__ void sample_unit(const Params& P, char* lds, int b, int g) {
    static_assert(PAST == 2048 && DEC_SEQ == 4 && PW == 512 && NCMP_S == 127 && NSEL_S == 33, "sample_unit is written for a 2048-token paged past and 4 new tokens");
    int tid, wave, lane, qrow, kk, t, r;
#define REFRESH_IDS() do { tid = threadIdx.x; asm volatile("" : "+v"(tid)); wave = __builtin_amdgcn_readfirstlane(tid >> 6); lane = tid & 63; qrow = lane & 15; kk = lane >> 4; t = qrow >> 2; r = qrow & 3; } while (0)
    REFRESH_IDS();
    const long tok0 = TOK_P + 4L * b;
    int* pages = (int*)(lds + L_PAGES); float* psum = (float*)(lds + L_PSUM); float* scv = (float*)(lds + L_SC); unsigned* selw = (unsigned*)(lds + L_SELW);
    if (tid < NPAGES) pages[tid] = P.ptab[b * NPAGES + tid];
    if (tid < 8) selw[tid] = 0u;
    { const int qr_ = tid >> 5, c4_ = tid & 31; float* qlw = (float*)(lds + L_QL);
      *(f32x4*)(qlw + qr_ * QL_LD + 4 * c4_) = *(const f32x4*)(P.ws + W_PROJ + (tok0 + (qr_ >> 2)) * LDP + C_Q + (4 * g + (qr_ & 3)) * 128 + 4 * c4_); }
    const float* q = (const float*)(lds + L_QL) + qrow * QL_LD + 8 * kk;
    __syncthreads();
    f32x4 o_slc, o_win;
    {
        Acc A; acc_init(A);
        if (wave == 0) {
            f32x4* sraw = (f32x4*)(lds + L_SRAW);
            run_blocks<true>(P, pages, 0, 0u | (1u << 6), 2, b, g, q, A, lane, 0u, 0u, sraw);
            REFRESH_IDS();
            const float inv = 1.0f / A.l;
#pragma unroll
            for (int ti = 0; ti < 8; ++ti) { const f32x4 sv = sraw[ti * 64 + lane];
#pragma unroll
                for (int i = 0; i < 4; ++i) { float p = __builtin_amdgcn_exp2f((sv[i] - A.m) * SC2) * inv; p += __shfl_xor(p, 1); p += __shfl_xor(p, 2);
                    if (r == 0) psum[t * 128 + 16 * ti + 4 * kk + i] = p; } }
            const int j = lane & 15, rg = lane >> 4;
#pragma unroll
            for (int rr = 0; rr < 4; ++rr) { const float il = __shfl(inv, 4 * rg + rr);
#pragma unroll
                for (int hf = 0; hf < 2; ++hf) *(f32x4*)(lds + L_OC + ((4 * rg + rr) * 128 + 64 * hf + 4 * j) * 4) = (f32x4){A.o[hf][0][rr], A.o[hf][1][rr], A.o[hf][2][rr], A.o[hf][3][rr]} * il; }
            acc_init(A);
        } else {
            const unsigned blist = (unsigned)(wave - 1) | ((unsigned)(6 + wave) << 6); const int nb = wave <= 2 ? 2 : 1;
            run_blocks<false>(P, pages, 2, blist, nb, b, g, q, A, lane, 0u, 0u, nullptr);
        }
        REFRESH_IDS();
        write_partial(lds, A, wave, lane);
    }
    __syncthreads();
    o_win = combine_partials(lds, tid);
    *(f32x4*)(lds + L_OW + tid * 16) = o_win;
    const int st = tid / NSEL_S, sj = tid % NSEL_S; float myscore = 0.f; bool allowed = false;
    if (tid < 4 * NSEL_S) {
        const int qpos = PAST + st, cur = qpos / 64;
        int n0 = 4 * sj - 1; if (n0 < 0) n0 = 0; int n1 = 4 * sj + 3; if (n1 > NCMP_S - 1) n1 = NCMP_S - 1;
        float imp = 0.f; for (int n = n0; n <= n1; ++n) imp += psum[st * 128 + n];
        allowed = sj * 64 <= qpos; const bool forced = (sj == 0) || (sj == cur) || (sj == cur - 1);
        myscore = allowed ? imp + (forced ? 1e6f : 0.0f) : -1e30f;
        scv[st * 40 + sj] = myscore;
    }
    __syncthreads();
    if (tid < 4 * NSEL_S) {
        int rank = 0;
        for (int j2 = 0; j2 < NSEL_S; ++j2) { const float o2 = scv[st * 40 + j2]; rank += (o2 > myscore || (o2 == myscore && j2 < sj)) ? 1 : 0; }
        if (allowed && rank < 16) atomicOr(&selw[st * 2 + (sj >> 5)], 1u << (sj & 31));
    }
    __syncthreads();
    {
        const unsigned ulo = selw[0] | selw[2] | selw[4] | selw[6], uhi = selw[1] | selw[3] | selw[5] | selw[7];
        unsigned blist = 0u; int nb = 0, cnt = 0;
        for (int j2 = 0; j2 < NSEL_S; ++j2) { const bool on = j2 < 32 ? ((ulo >> j2) & 1u) : ((uhi >> (j2 - 32)) & 1u); if (on) { if ((cnt & 7) == wave) { blist |= (unsigned)j2 << (6 * nb); ++nb; } ++cnt; } }
        Acc A; acc_init(A);
        run_blocks<false>(P, pages, 1, blist, nb, b, g, q, A, lane, selw[2 * t], selw[2 * t + 1], nullptr);
        REFRESH_IDS();
        write_partial(lds, A, wave, lane);
        __syncthreads();
        o_slc = combine_partials(lds, tid);
    }
    {
        REFRESH_IDS(); o_win = *(const f32x4*)(lds + L_OW + tid * 16);
        const int orow = tid >> 5, d4 = tid & 31, ot = orow >> 2, h = 4 * g + (orow & 3); const long tok = tok0 + ot; const float* pr = P.ws + W_PROJ + tok * LDP;
        const float g0 = sigmoid_f(pr[C_GATE + h]), g1 = sigmoid_f(pr[C_GATE + 8 + h]), g2 = sigmoid_f(pr[C_GATE + 16 + h]);
        const f32x4 oc = *(const f32x4*)(lds + L_OC + (orow * 128 + 4 * d4) * 4), z = *(const f32x4*)(pr + C_ZN + h * 128 + 4 * d4);
        const f32x4 o = oc * g0 + o_slc * g1 + o_win * g2; f32x4 m;
        m.x = o.x * silu_f(z.x); m.y = o.y * silu_f(z.y); m.z = o.z * silu_f(z.z); m.w = o.w * silu_f(z.w);
        *(f32x4*)(P.ws + W_MIX + tok * D + h * 128 + 4 * d4) = m;
        typedef _Float16 h2v __attribute__((ext_vector_type(2))); typedef unsigned u32x2v __attribute__((ext_vector_type(2)));
        h2v p0, p1; p0.x = (_Float16)m.x; p0.y = (_Float16)m.y; p1.x = (_Float16)m.z; p1.y = (_Float16)m.w;
        u32x2v w2; w2.x = __builtin_bit_cast(unsigned, p0); w2.y = __builtin_bit_cast(unsigned, p1);
        *(u32x2v*)((_Float16*)(P.ws + W_MIX16) + tok * D + h * 128 + 4 * d4) = w2;
    }
    __syncthreads();
#undef REFRESH_IDS
}
}

namespace cmpa {
using fa::h8; using fa::f32x16; using fa::SHM_K; using fa::SHM_V;
constexpr int L_V = 0, L_K = 2 * SHM_V, L_PS = 65536, PS_LD = 129, L_SC = L_PS + 64 * PS_LD * 4, SC_LD = 33, L_END = L_SC + 64 * SC_LD * 4;
__device__ __forceinline__ h8 cvt8f(const float* p, bool ok) {
    typedef float f4 __attribute__((ext_vector_type(4))); typedef unsigned u4 __attribute__((ext_vector_type(4)));
    f4 a = (f4){0.f, 0.f, 0.f, 0.f}, b = a; if (ok) { a = *(const f4*)p; b = *(const f4*)(p + 4); }
    u4 w = {fa::cvtpk(a.x, a.y), fa::cvtpk(a.z, a.w), fa::cvtpk(b.x, b.y), fa::cvtpk(b.z, b.w)}; return __builtin_bit_cast(h8, w);
}
__device__ __forceinline__ void pack_frags(const f32x16& p0, const f32x16& p1, h8& pa0, h8& pa1, h8& pa2, h8& pa3) {
    typedef unsigned u4 __attribute__((ext_vector_type(4)));
#define PK4(P, B_, OUT) do { unsigned a0 = fa::cvtpk(P[B_+0], P[B_+1]), a1 = fa::cvtpk(P[B_+2], P[B_+3]);                          \
        unsigned b0 = fa::cvtpk(P[B_+4], P[B_+5]), b1 = fa::cvtpk(P[B_+6], P[B_+7]);                                             \
        auto r0 = __builtin_amdgcn_permlane32_swap(a0, b0, false, false); auto r1 = __builtin_amdgcn_permlane32_swap(a1, b1, false, false); \
        u4 w = {r0[0], r1[0], r0[1], r1[1]}; OUT = __builtin_bit_cast(h8, w); } while (0)
    PK4(p0, 0, pa0); PK4(p0, 8, pa1); PK4(p1, 0, pa2); PK4(p1, 8, pa3);
#undef PK4
}
__device__ __forceinline__ void unit(const Params& P, char* lds, int b, int g, int tt) {
    static_assert(NCMP_P == 127 && NSEL_P == 32, "cmpa::unit is written for 2048 prompt tokens");
    int tid = threadIdx.x; asm volatile("" : "+v"(tid));
    const int wid = __builtin_amdgcn_readfirstlane(tid >> 6), lane = tid & 63, r32 = lane & 31, hi = lane >> 5;
    const int hr = wid & 3, tsub = wid >> 2, h = 4 * g + hr, tl = 32 * tsub + r32, t_abs = 64 * tt + tl; const long tokw0 = (long)b * SEQ + 64 * tt + 32 * tsub;
    char* V_lds = lds + L_V; char* K_lds = lds + L_K; float* psum = (float*)(lds + L_PS); float* scv = (float*)(lds + L_SC);
    h8 qr[8];
#pragma unroll
    for (int d0 = 0; d0 < 8; ++d0) qr[d0] = fa::load8((const _Float16*)(P.ws + W_Q16) + (tokw0 + r32) * 1024 + h * 128 + d0 * 16 + hi * 8);
    { const int sr = tid >> 4, sc = (tid & 15) * 8;
#pragma unroll
      for (int tile = 0; tile < 2; ++tile)
#pragma unroll
          for (int hf = 0; hf < 2; ++hf) { const int n = 64 * tile + 32 * hf + sr; const bool ok = n < NCMP_P;
              const float* src = P.ws + W_KC + (((long)b * NCMPX + (ok ? n : 0)) * 4 + g) * 128 + sc;
              *(h8*)(K_lds + tile * SHM_K + ((sr) * 256 + ((sc * 2) ^ (((sr) & 7) << 4))) + hf * 32 * 256) = cvt8f(src, ok);
              *(h8*)(V_lds + tile * SHM_V + fa::v_st(32 * hf + sr, sc)) = cvt8f(src + 256, ok); } }
    __syncthreads();
    f32x16 pA0, pA1, pB0, pB1;
    fa::qkt<0>(pA0, pA1, K_lds, r32, hi, qr); fa::qkt<1>(pB0, pB1, K_lds, r32, hi, qr);
    const int nmax = t_abs >= 31 ? (t_abs - 31) >> 4 : -1; const float NEG = -__builtin_inff();
    float mx = NEG;
#pragma unroll
    for (int r = 0; r < 16; ++r) { const int c = (r & 3) + 8 * (r >> 2) + 4 * hi;
        pA0[r] = (c <= nmax) ? pA0[r] : NEG; pA1[r] = (c + 32 <= nmax) ? pA1[r] : NEG; pB0[r] = (c + 64 <= nmax) ? pB0[r] : NEG; pB1[r] = (c + 96 <= nmax) ? pB1[r] : NEG;
        mx = fmaxf(fmaxf(mx, pA0[r]), fmaxf(pA1[r], fmaxf(pB0[r], pB1[r]))); }
    { auto rr = __builtin_amdgcn_permlane32_swap(__float_as_uint(mx), __float_as_uint(mx), false, false); mx = fmaxf(__uint_as_float(rr[0]), __uint_as_float(rr[1])); }
    if (!(mx > -1e30f)) mx = 0.f;
    constexpr float C2 = 1.4426950408889634f * fa::SCALE; const float mnL = -mx * C2; float ps = 0.f;
#pragma unroll
    for (int r = 0; r < 16; ++r) { pA0[r] = __builtin_amdgcn_exp2f(fmaf(pA0[r], C2, mnL)); pA1[r] = __builtin_amdgcn_exp2f(fmaf(pA1[r], C2, mnL));
        pB0[r] = __builtin_amdgcn_exp2f(fmaf(pB0[r], C2, mnL)); pB1[r] = __builtin_amdgcn_exp2f(fmaf(pB1[r], C2, mnL)); ps += (pA0[r] + pA1[r]) + (pB0[r] + pB1[r]); }
    { auto rr = __builtin_amdgcn_permlane32_swap(__float_as_uint(ps), __float_as_uint(ps), false, false); ps = __uint_as_float(rr[0]) + __uint_as_float(rr[1]); }
    const float inv = ps > 0.f ? 1.0f / ps : 0.f;
#pragma unroll
    for (int r = 0; r < 16; ++r) { pA0[r] *= inv; pA1[r] *= inv; pB0[r] *= inv; pB1[r] *= inv; }
#pragma unroll
    for (int rnd = 0; rnd < 4; ++rnd) {
        if (hr == rnd) {
#pragma unroll
            for (int r = 0; r < 16; ++r) { const int c = (r & 3) + 8 * (r >> 2) + 4 * hi; float* q_ = psum + tl * PS_LD + c;
                if (rnd == 0) { q_[0] = pA0[r]; q_[32] = pA1[r]; q_[64] = pB0[r]; q_[96] = pB1[r]; }
                else { q_[0] += pA0[r]; q_[32] += pA1[r]; q_[64] += pB0[r]; q_[96] += pB1[r]; } } }
        __syncthreads();
    }
    {
        f32x16 o[4] = {}; h8 pa0, pa1, pa2, pa3; const int vb0 = (int)(uintptr_t)V_lds + fa::v_rd_base(lane);
        pack_frags(pA0, pA1, pa0, pa1, pa2, pa3); fa::pv_tile<0>(o, vb0, pa0, pa1, pa2, pa3);
        pack_frags(pB0, pB1, pa0, pa1, pa2, pa3); fa::pv_tile<1>(o, vb0, pa0, pa1, pa2, pa3);
        float* Ow = P.ws + W_OCMP + tokw0 * 1024 + h * 128;
#pragma unroll
        for (int r = 0; r < 16; ++r) { const int orow = fa::crow(r, hi);
#pragma unroll
            for (int d0 = 0; d0 < 4; ++d0) Ow[(size_t)orow * 1024 + d0 * 32 + r32] = o[d0][r]; }
    }
#pragma unroll
    for (int it = 0; it < 4; ++it) { const int idx = it * 512 + tid, t = idx >> 5, j = idx & 31, qpos = 64 * tt + t, cur = qpos >> 6;
        int n0 = 4 * j - 1; if (n0 < 0) n0 = 0; int n1 = 4 * j + 3; if (n1 > NCMP_P - 1) n1 = NCMP_P - 1;
        float imp = 0.f; for (int n = n0; n <= n1; ++n) imp += psum[t * PS_LD + n];
        const bool allowed = j * 64 <= qpos, forced = (j == 0) || (j == cur) || (j == cur - 1);
        scv[t * SC_LD + j] = allowed ? imp + (forced ? 1e6f : 0.0f) : -1e30f; }
    __syncthreads();
#pragma unroll
    for (int it = 0; it < 4; ++it) { const int idx = it * 512 + tid, t = idx >> 5, j = idx & 31, qpos = 64 * tt + t;
        const float my = scv[t * SC_LD + j]; int rank = 0;
        for (int j2 = 0; j2 < 32; ++j2) { const float o2 = scv[t * SC_LD + j2]; rank += (o2 > my || (o2 == my && j2 < j)) ? 1 : 0; }
        const bool sel = (j * 64 <= qpos) && rank < 16;
        const unsigned long long bal = __ballot(sel);
        if ((lane & 31) == 0) { unsigned* o = (unsigned*)(P.ws + W_SEL) + (((long)b * SEQ + qpos) * 2 + g) * 2; o[0] = (unsigned)(lane == 0 ? bal : (bal >> 32)); o[1] = 0u; } }
    __syncthreads();
}
}


namespace cvb {
template <int TC, bool HEAD>
__device__ __forceinline__ void conv_unit(const Params& P, char* lds, int seq, int t0r) {
    const int t0 = t0r;
    int tid = threadIdx.x; asm volatile("" : "+v"(tid));
    const int wave = __builtin_amdgcn_readfirstlane(tid >> 6), lane = tid & 63;
    constexpr int NTH_ = 512, NR = TC + CONVW - 1, NIT = (NR * 256 + NTH_ - 1) / NTH_;
    static_assert(NR * 2048 + TC * 2048 + TC * 64 <= 131072, "LDS map");
    typedef float f4 __attribute__((ext_vector_type(4))); typedef float f2 __attribute__((ext_vector_type(2))); typedef unsigned u2 __attribute__((ext_vector_type(2))); typedef _Float16 h2v __attribute__((ext_vector_type(2)));
    _Float16* ul = (_Float16*)lds; _Float16* cvl = (_Float16*)(lds + NR * 2048); float* red = (float*)(lds + NR * 2048 + TC * 2048);
    const long tokb = tok_of(seq, 0);
#pragma unroll
    for (int it0 = 0; it0 < NIT; it0 += 16) {
        f4 v[16];
#pragma unroll
        for (int q = 0; q < 16; ++q) { const int it = it0 + q, e = it * NTH_ + tid, r = e >> 8, c4 = e & 255; v[q] = (f4){0.f, 0.f, 0.f, 0.f};
            if (it < NIT && r < NR) { const float* src = nullptr;
                const int idx = t0 + r;
                if (HEAD && idx < 30) { if (seq >= BATCH) src = P.sconv + ((long)(seq - BATCH) * 30 + idx) * 1024; }
                else src = P.ws + W_U + (tokb + idx - 30) * 1024;
                if (src) v[q] = *(const f4*)(src + 4 * c4); } }
#pragma unroll
        for (int q = 0; q < 16; ++q) { const int it = it0 + q, e = it * NTH_ + tid, r = e >> 8, c4 = e & 255;
            if (it < NIT && r < NR) { h2v p0, p1; p0.x = (_Float16)v[q].x; p0.y = (_Float16)v[q].y; p1.x = (_Float16)v[q].z; p1.y = (_Float16)v[q].w;
                u2 w; w.x = __builtin_bit_cast(unsigned, p0); w.y = __builtin_bit_cast(unsigned, p1); *(u2*)(ul + r * 1024 + 4 * c4) = w; } }
    }
    float w0[CONVW], w1[CONVW];
#pragma unroll
    for (int k = 0; k < CONVW; ++k) { const f2 ww = *(const f2*)(P.dw + k * 1024 + 2 * tid); w0[k] = ww.x; w1[k] = ww.y; }
    const f2 bb = *(const f2*)(P.db + 2 * tid);
    __syncthreads();
#pragma unroll 1
    for (int tt = 0; tt < TC; ++tt) {
        float a0 = bb.x, a1 = bb.y;
#pragma unroll
        for (int k = 0; k < CONVW; ++k) { const h2v uu = *(const h2v*)(ul + (tt + k) * 1024 + 2 * tid); a0 += w0[k] * (float)uu.x; a1 += w1[k] * (float)uu.y; }
        h2v cc; cc.x = (_Float16)a0; cc.y = (_Float16)a1; *(h2v*)(cvl + tt * 1024 + 2 * tid) = cc;
        const float c0 = (float)cc.x, c1 = (float)cc.y; float s1 = c0 + c1, s2 = c0 * c0 + c1 * c1;
#pragma unroll
        for (int o = 1; o < 64; o <<= 1) { s1 += __shfl_xor(s1, o); s2 += __shfl_xor(s2, o); }
        if (lane == 0) { red[(tt * 8 + wave) * 2] = s1; red[(tt * 8 + wave) * 2 + 1] = s2; }
    }
    __syncthreads();
    { const _Float16* zsrc = (const _Float16*)(P.ws + W_ZC16) + (tokb + t0) * 1024;
      typedef unsigned u4 __attribute__((ext_vector_type(4)));
#pragma unroll
      for (int it = 0; it < (TC * 128 + NTH_ - 1) / NTH_; ++it) { const int e = it * NTH_ + tid; if (e < TC * 128) *(u4*)(ul + e * 8) = *(const u4*)(zsrc + e * 8); } }
    const f2 gg = *(const f2*)(P.lng + 2 * tid), be = *(const f2*)(P.lnb + 2 * tid);
    __syncthreads();
#pragma unroll 1
    for (int tt = 0; tt < TC; ++tt) {
        float s1 = 0.f, s2 = 0.f;
#pragma unroll
        for (int w = 0; w < 8; ++w) { s1 += red[(tt * 8 + w) * 2]; s2 += red[(tt * 8 + w) * 2 + 1]; }
        const float mu = s1 * (1.0f / 1024), var = s2 * (1.0f / 1024) - mu * mu, rstd = rsqrtf(fmaxf(var, 0.f) + 1e-6f);
        const h2v cc = *(const h2v*)(cvl + tt * 1024 + 2 * tid), zz = *(const h2v*)(ul + tt * 1024 + 2 * tid);
        const float l0 = ((float)cc.x - mu) * rstd * gg.x + be.x, l1 = ((float)cc.y - mu) * rstd * gg.y + be.y;
        h2v mm; mm.x = (_Float16)(l0 / (1.0f + __expf(-l0)) * (float)zz.x); mm.y = (_Float16)(l1 / (1.0f + __expf(-l1)) * (float)zz.y);
        *(h2v*)((_Float16*)(P.ws + W_MIX16) + (tokb + t0 + tt) * D + 1024 + 2 * tid) = mm;
    }
    __syncthreads();
}
}

#define XB_TMO      128
#define XB_XCNT(j)  (256  + 64 * (j))
#define XB_XSUB(j)  (1280 + 64 * (j))
#define XB_XGEN(j)  (2304 + 64 * (j))
#define XB_TOP      3328
#define XB_TOPGEN   3392
#define XCD_BAR_WORDS 3456
#define XB_SPIN_CAP (1u << 22)
__device__ __forceinline__ unsigned xb_ld(unsigned* p)              { return __hip_atomic_load(p, __ATOMIC_RELAXED, __HIP_MEMORY_SCOPE_AGENT); }
__device__ __forceinline__ unsigned xb_add(unsigned* p, unsigned v) { return __hip_atomic_fetch_add(p, v, __ATOMIC_RELAXED, __HIP_MEMORY_SCOPE_AGENT); }
__device__ __forceinline__ unsigned xb_xcc_id() { return (unsigned)__builtin_amdgcn_s_getreg((3 << 11) | 20) & 0xFu; }
#define XB_SPIN(cond, bar) do { unsigned _sp = 0; while (cond) { __builtin_amdgcn_s_sleep(1); \
    if ((++_sp & 255u) == 0u) { if (xb_ld(&(bar)[XB_TMO])) break; if (_sp > XB_SPIN_CAP) { atomicAdd(&(bar)[XB_TMO], 1u); break; } } } } while (0)
struct XcdBarrier { unsigned* bar; unsigned x; volatile LAS unsigned* st; };
__device__ __forceinline__ XcdBarrier xcd_barrier_post(unsigned* bar, volatile LAS unsigned* st) {
    XcdBarrier b; b.bar = bar; b.x = xb_xcc_id(); b.st = st;
    if (threadIdx.x == 0) (void)xb_add(&bar[XB_XCNT(b.x)], 1u);
    return b;
}
__device__ __forceinline__ void xcd_barrier_complete(unsigned* bar, unsigned x, unsigned& nloc, unsigned& nx) {
    const unsigned G = gridDim.x * gridDim.y * gridDim.z;
    unsigned sum, cnt, mine, sp = 0u;
    for (;;) {
        sum = 0u; cnt = 0u; mine = 0u;
#pragma unroll
        for (unsigned j = 0; j < 16; ++j) { const unsigned c = xb_ld(&bar[XB_XCNT(j)]); sum += c; cnt += (c > 0u) ? 1u : 0u; mine = (j == x) ? c : mine; }
        if (sum == G) break;
        __builtin_amdgcn_s_sleep(1);
        if ((++sp & 255u) == 0u) { if (xb_ld(&bar[XB_TMO])) break; if (sp > XB_SPIN_CAP) { atomicAdd(&bar[XB_TMO], 1u); break; } }
    }
    nloc = mine > 0u ? mine : 1u; nx = cnt > 0u ? cnt : 1u;
}
__device__ __forceinline__ void xcd_barrier(const XcdBarrier& b) {
    asm volatile("s_waitcnt vmcnt(0)" ::: "memory");
    __syncthreads();
    if (threadIdx.x == 0) {
        unsigned* bar = b.bar;
        __builtin_amdgcn_s_waitcnt(0);
        unsigned nloc = b.st[0], nx = b.st[1];
        if (nloc == 0u) { xcd_barrier_complete(bar, b.x, nloc, nx); b.st[0] = nloc; b.st[1] = nx; }
        const unsigned old = xb_add(&bar[XB_XSUB(b.x)], 1u);
        const unsigned gen = old / nloc;
        if (old + 1u == (gen + 1u) * nloc) {
            __builtin_amdgcn_fence(__ATOMIC_RELEASE, "agent");
            asm volatile("s_waitcnt vmcnt(0)" ::: "memory");
            const unsigned og = xb_add(&bar[XB_TOP], 1u);
            const unsigned tg = og / nx;
            if (og + 1u == (tg + 1u) * nx) xb_add(&bar[XB_TOPGEN], 1u);
            else XB_SPIN(xb_ld(&bar[XB_TOPGEN]) == tg, bar);
            __builtin_amdgcn_fence(__ATOMIC_ACQUIRE, "agent");
            xb_add(&bar[XB_XGEN(b.x)], 1u);
            asm volatile("s_waitcnt vmcnt(0)" ::: "memory");
        } else {
            XB_SPIN(xb_ld(&bar[XB_XGEN(b.x)]) == gen, bar);
            __builtin_amdgcn_fence(__ATOMIC_ACQUIRE, "agent");
            asm volatile("s_waitcnt vmcnt(0)" ::: "memory");
        }
    }
    __syncthreads();
}

constexpr int NTHREADS = 512, NWAVES = 8;
constexpr int LDS_BYTES = 147456;
constexpr int LDS_MISC = 131072;
constexpr int CW_BAR = 4096;
constexpr int CW_QATT = 8192;

namespace modb {
typedef _Float16 h8 __attribute__((ext_vector_type(8)));
typedef float f32x4 __attribute__((ext_vector_type(4)));
typedef unsigned u32x4 __attribute__((ext_vector_type(4)));
constexpr int MT = (NSEQ + 15) / 16, N_ITEMS = 2 * (6144 / 128);
__device__ __forceinline__ unsigned pk(float lo, float hi) { typedef _Float16 h2v __attribute__((ext_vector_type(2))); h2v p; p.x = (_Float16)lo; p.y = (_Float16)hi; return __builtin_bit_cast(unsigned, p); }
__device__ __forceinline__ void mod_item(const Params& P, char* lds, int item) {
    int tid = threadIdx.x; asm volatile("" : "+v"(tid));
    const int wave = __builtin_amdgcn_readfirstlane(tid >> 6), lane = tid & 63, r16 = lane & 15, kg = lane >> 4;
    const int kh = item & 1, n0 = (item >> 1) * 128 + wave * 16;
    f32x4 acc[MT];
#pragma unroll
    for (int i = 0; i < MT; ++i) acc[i] = (f32x4){0.f, 0.f, 0.f, 0.f};
    for (int ch = kh * (D / 512); ch < (kh + 1) * (D / 512); ++ch) {
        const float* wp = P.w_ada + (long)(256 * ch + 8 * kg) * 6144 + n0 + r16;
        float wv[8][8];
#pragma unroll
        for (int ks = 0; ks < 8; ++ks)
#pragma unroll
            for (int j = 0; j < 8; ++j) wv[ks][j] = wp[(long)(32 * ks + j) * 6144];
        __builtin_amdgcn_sched_barrier(0);
        static_assert(MT * 16 * 32 == 9 * NTHREADS, "slab items per thread");
        f32x4 ca[9], cb[9];
#pragma unroll
        for (int it = 0; it < 9; ++it) { const int idx = tid + it * NTHREADS, m = idx >> 5, ck = idx & 31; ca[it] = (f32x4){0.f, 0.f, 0.f, 0.f}; cb[it] = ca[it];
            if (m < NSEQ) { const float* c = (m < BATCH ? P.c_p + (long)m * D : P.c_s + (long)(m - BATCH) * D) + 256 * ch + 8 * ck; ca[it] = *(const f32x4*)c; cb[it] = *(const f32x4*)(c + 4); } }
#pragma unroll
        for (int it = 0; it < 9; ++it) { const int idx = tid + it * NTHREADS, m = idx >> 5, ck = idx & 31; const f32x4 a = ca[it], b = cb[it];
#define SL_(x) ((x) / (1.0f + __expf(-(x))))
            u32x4 w = {pk(SL_(a.x), SL_(a.y)), pk(SL_(a.z), SL_(a.w)), pk(SL_(b.x), SL_(b.y)), pk(SL_(b.z), SL_(b.w))};
#undef SL_
            *(u32x4*)(lds + m * 512 + ((ck ^ (m & 15)) << 4)) = w; }
        __syncthreads();
#pragma unroll
        for (int ks = 0; ks < 8; ++ks) {
            u32x4 bw = {pk(wv[ks][0], wv[ks][1]), pk(wv[ks][2], wv[ks][3]), pk(wv[ks][4], wv[ks][5]), pk(wv[ks][6], wv[ks][7])}; const h8 bf = __builtin_bit_cast(h8, bw);
#pragma unroll
            for (int mt = 0; mt < MT; ++mt) { const h8 af = *(const h8*)(lds + (16 * mt + r16) * 512 + (((4 * ks + kg) ^ r16) << 4)); acc[mt] = __builtin_amdgcn_mfma_f32_16x16x32_f16(af, bf, acc[mt], 0, 0, 0); }
        }
        __syncthreads();
    }
    const float bj = kh ? 0.f : P.b_ada[n0 + r16]; float* mo = P.ws + (kh ? W_MOD2 : W_MOD);
#pragma unroll
    for (int mt = 0; mt < MT; ++mt)
#pragma unroll
        for (int i = 0; i < 4; ++i) { const int seq = 16 * mt + 4 * kg + i; if (seq < NSEQ) mo[(long)seq * 6144 + n0 + r16] = acc[mt][i] + bj; }
}
}


typedef float f32x4 __attribute__((ext_vector_type(4)));
typedef _Float16 h2_t __attribute__((ext_vector_type(2)));
typedef unsigned u32x4 __attribute__((ext_vector_type(4)));
typedef unsigned u32x2 __attribute__((ext_vector_type(2)));
__device__ __forceinline__ unsigned pk2h(float lo, float hi) { h2_t p; p.x = (_Float16)lo; p.y = (_Float16)hi; return __builtin_bit_cast(unsigned, p); }
__device__ __forceinline__ float wave_sum(float v) {
#pragma unroll
    for (int o = 1; o < 64; o <<= 1) v += __shfl_xor(v, o);
    return v;
}
#define LDS_WAIT() asm volatile("s_waitcnt lgkmcnt(0)" ::: "memory")

__device__ __forceinline__ void transpose_item(const float* W, int ldw, int K, _Float16* WT, int n0, int src0, int valid, int kb, LAS float* scr, int lane) {
    const int k0 = 64 * kb, c31 = lane & 31;
    float tv[32];
#pragma unroll
    for (int i = 0; i < 32; ++i) { const int kk = 2 * i + (lane >> 5); tv[i] = (c31 < valid) ? W[(size_t)(k0 + kk) * ldw + src0 + c31] : 0.f; }
#pragma unroll
    for (int i = 0; i < 32; ++i) { const int kk = 2 * i + (lane >> 5); scr[kk * 33 + c31] = tv[i]; }
    LDS_WAIT(); asm volatile("" ::: "memory");
    const int c = lane & 7;
#pragma unroll
    for (int j = 0; j < 4; ++j) { const int n = (lane >> 3) + 8 * j; const LAS float* sp = scr + (8 * c) * 33 + n;
        u32x4 o; o.x = pk2h(sp[0 * 33], sp[1 * 33]); o.y = pk2h(sp[2 * 33], sp[3 * 33]); o.z = pk2h(sp[4 * 33], sp[5 * 33]); o.w = pk2h(sp[6 * 33], sp[7 * 33]);
        *(u32x4*)(WT + (size_t)(n0 + n) * K + k0 + 8 * c) = o; }
    LDS_WAIT(); asm volatile("" ::: "memory");
}
__device__ __forceinline__ void h_row(const Params& P, int tok, int lane) {
    int seq, t, pos0; tokinfo(tok, seq, t, pos0);
    const f32x4* xr = (const f32x4*)xrow(P, tok) + lane;
    f32x4 v[8]; float s = 0.f;
#pragma unroll
    for (int j = 0; j < 8; ++j) { v[j] = xr[64 * j]; s += (v[j].x * v[j].x + v[j].y * v[j].y) + (v[j].z * v[j].z + v[j].w * v[j].w); }
    const float rstd = rsqrtf(wave_sum(s) * (1.0f / D) + 1e-6f);
    const float* mod = P.ws + W_MOD + (long)seq * 6144;
    _Float16* hrow = (_Float16*)(P.ws + W_H16) + (long)tok * D;
#pragma unroll
    for (int j = 0; j < 8; ++j) { const int idx = 4 * (64 * j + lane);
        const float* mod2 = mod + (W_MOD2 - W_MOD);
        const f32x4 np = *(const f32x4*)(P.npre + idx), sc = *(const f32x4*)(mod + D + idx) + *(const f32x4*)(mod2 + D + idx), sh = *(const f32x4*)(mod + idx) + *(const f32x4*)(mod2 + idx);
        const f32x4 h = v[j] * rstd * np * (1.0f + sc) + sh;
        u32x2 o; o.x = pk2h(h.x, h.y); o.y = pk2h(h.z, h.w);
        *(u32x2*)(hrow + idx) = o; }
}


__device__ __forceinline__ void mod_wave(const Params& P, int sgrp, int jb, int lane) {
    constexpr int NS = 6; static_assert(NSEQ % NS == 0, "sequence groups");
    const int j = jb * 64 + lane; float acc[NS];
#pragma unroll
    for (int q = 0; q < NS; ++q) acc[q] = 0.f;
    for (int k0 = 0; k0 < D; k0 += 64) {
        float sc[NS];
#pragma unroll
        for (int q = 0; q < NS; ++q) { const int seq = sgrp * NS + q; const float* c = seq < BATCH ? P.c_p + (long)seq * D : P.c_s + (long)(seq - BATCH) * D; sc[q] = silu_f(c[k0 + lane]); }
#pragma unroll
        for (int kk = 0; kk < 64; ++kk) { const float w = P.w_ada[(long)(k0 + kk) * 6144 + j];
#pragma unroll
            for (int q = 0; q < NS; ++q) acc[q] += __builtin_bit_cast(float, __builtin_amdgcn_readlane(__builtin_bit_cast(int, sc[q]), kk)) * w; }
    }
    const float bj = P.b_ada[j];
#pragma unroll
    for (int q = 0; q < NS; ++q) P.ws[W_MOD + (long)(sgrp * NS + q) * 6144 + j] = acc[q] + bj;
}
__device__ __forceinline__ void mixconv_row(const Params& P, int tok, int lane) {
    const f32x4* cr = (const f32x4*)(P.ws + W_CV + (long)tok * 1024) + lane;
    f32x4 v[4]; float s = 0.f;
#pragma unroll
    for (int j = 0; j < 4; ++j) { v[j] = cr[64 * j]; s += (v[j].x + v[j].y) + (v[j].z + v[j].w); }
    const float mu = wave_sum(s) * (1.0f / 1024); float q = 0.f;
#pragma unroll
    for (int j = 0; j < 4; ++j) { v[j] = v[j] - mu; q += (v[j].x * v[j].x + v[j].y * v[j].y) + (v[j].z * v[j].z + v[j].w * v[j].w); }
    const float rstd = rsqrtf(wave_sum(q) * (1.0f / 1024) + 1e-6f);
#pragma unroll
    for (int j = 0; j < 4; ++j) { const int c = 4 * (64 * j + lane);
        const f32x4 g = *(const f32x4*)(P.lng + c), b = *(const f32x4*)(P.lnb + c), z = *(const f32x4*)(P.ws + W_PROJ + (long)tok * LDP + C_ZC + c);
        const f32x4 ln = v[j] * rstd * g + b; f32x4 m;
        m.x = silu_f(ln.x) * silu_f(z.x); m.y = silu_f(ln.y) * silu_f(z.y); m.z = silu_f(ln.z) * silu_f(z.z); m.w = silu_f(ln.w) * silu_f(z.w);
        *(f32x4*)(P.ws + W_MIX + (long)tok * D + 1024 + c) = m;
        u32x2 o; o.x = pk2h(m.x, m.y); o.y = pk2h(m.z, m.w);
        *(u32x2*)((_Float16*)(P.ws + W_MIX16) + (long)tok * D + 1024 + c) = o; }
}
__device__ __forceinline__ void y_row(const Params& P, int tok, int lane) {
    int seq, t, pos0; tokinfo(tok, seq, t, pos0);
    const f32x4* orow = (const f32x4*)(P.ws + W_O2 + (long)tok * D) + lane; const f32x4* xr = (const f32x4*)xrow(P, tok) + lane;
    f32x4 v[8]; float s = 0.f;
#pragma unroll
    for (int j = 0; j < 8; ++j) { v[j] = orow[64 * j]; s += (v[j].x * v[j].x + v[j].y * v[j].y) + (v[j].z * v[j].z + v[j].w * v[j].w); }
    const float rstd = rsqrtf(wave_sum(s) * (1.0f / D) + 1e-6f);
    const float* gate = P.ws + W_MOD + (long)seq * 6144 + 2 * D;
    float* yrow = P.out + (tok < TOK_P ? O_YP + (long)tok * D : O_YS + (long)(tok - TOK_P) * D);
#pragma unroll
    for (int j = 0; j < 8; ++j) { const int idx = 4 * (64 * j + lane);
        const f32x4 g = *(const f32x4*)(gate + idx) + *(const f32x4*)(gate + (W_MOD2 - W_MOD) + idx), np = *(const f32x4*)(P.npost + idx), x = xr[64 * j];
        *(f32x4*)(yrow + idx) = x + g * (v[j] * rstd * np); }
}

__device__ __forceinline__ void combine_row(const Params& P, int tok, int lane) {
    const float* gt = P.ws + W_GATES + (long)tok * 32; const _Float16* zn = (const _Float16*)(P.ws + W_ZN16) + (long)tok * 1024;
    _Float16* mo = (_Float16*)(P.ws + W_MIX16) + (long)tok * D;
#pragma unroll
    for (int j = 0; j < 4; ++j) { const int c = 4 * (64 * j + lane), h = c >> 7; const float g0 = gt[h], g1 = gt[8 + h], g2 = gt[16 + h];
        const f32x4 a = *(const f32x4*)(P.ws + W_OCMP + (long)tok * 1024 + c), b = *(const f32x4*)(P.ws + W_OSLC + (long)tok * 1024 + c), w = *(const f32x4*)(P.ws + W_OWIN + (long)tok * 1024 + c);
        typedef _Float16 h4_t __attribute__((ext_vector_type(4))); const h4_t z = *(const h4_t*)(zn + c);
        const f32x4 o = a * g0 + b * g1 + w * g2;
        u32x2 r; r.x = pk2h(o.x * (float)z.x, o.y * (float)z.y); r.y = pk2h(o.z * (float)z.z, o.w * (float)z.w);
        *(u32x2*)(mo + c) = r; }
}

__global__ void __launch_bounds__(NTHREADS, 2) fwd_kernel(Params P) {
    extern __shared__ __attribute__((aligned(16))) unsigned char lds_raw[];
    LAS unsigned char* lds = (LAS unsigned char*)lds_raw;
    volatile LAS unsigned* misc = (volatile LAS unsigned*)(lds + LDS_MISC);
    if (threadIdx.x < 64) misc[threadIdx.x] = 0u;
    __syncthreads();
    XcdBarrier bar = xcd_barrier_post((unsigned*)P.ws + CW_BAR, misc + 8);
    const int G = gridDim.x;
#define OTID() ({ int t_ = threadIdx.x; asm volatile("" : "+v"(t_)); t_; })
#define RUN(n, fn) { const int t_ = OTID(); const long _n = (n), _g0 = (long)blockIdx.x * NTHREADS + t_, gsz_ = (long)G * NTHREADS; for (long _i = _g0; _i < _n; _i += gsz_) fn(P, _i); }
#define RUN_OFF(n, off, fn) { const int t_ = OTID(); const long _n = (n), _o = (off), _g0 = (long)blockIdx.x * NTHREADS + t_, gsz_ = (long)G * NTHREADS; for (long _i = _g0; _i < _n; _i += gsz_) fn(P, _i + _o); }
    {
    const int NMOD = G > 2 * modb::N_ITEMS ? modb::N_ITEMS : 0;
    if (NMOD == 0 || (int)blockIdx.x < NMOD) { for (int it = blockIdx.x; it < modb::N_ITEMS; it += (NMOD ? NMOD : G)) modb::mod_item(P, (char*)lds_raw, it); }
    if (NMOD == 0 || (int)blockIdx.x >= NMOD) {
        const int bx = (int)blockIdx.x - NMOD, GP = G - NMOD;
#define RUNP(n, fn) { const int t_ = OTID(); const long _n = (n), _g0 = (long)bx * NTHREADS + t_, gsz_ = (long)GP * NTHREADS; for (long _i = _g0; _i < _n; _i += gsz_) fn(P, _i); }
        RUNP(2L * 256 * 2048, it_wc16); RUNP(2L * 128 * 128, it_w2t16); RUNP(2L * 32 * 128, it_cconst_part);
#undef RUNP
        const int tid = OTID(), lane = tid & 63, wave = __builtin_amdgcn_readfirstlane(tid >> 6), gw = bx * NWAVES + wave, NGW = GP * NWAVES;
        LAS float* scr = (LAS float*)(lds + wave * 16384);
        constexpr int I_IN = (D / 64) * (LDP / 32), I_OUT = (D / 64) * (D / 32);
        for (int it = gw; it < I_IN + I_OUT; it += NGW) {
            if (it < I_IN) { const int kb = it / (LDP / 32), nb = it % (LDP / 32), n0 = 32 * nb; const int src = proj_src_col(n0);
                int valid = src < 0 ? 0 : 32; if (n0 == C_GATE) valid = 24;
                transpose_item(P.w_in, IN_COLS, D, (_Float16*)(P.ws + W_WTIN), n0, src < 0 ? 0 : src, valid, kb, scr, lane); }
            else { const int r = it - I_IN, kb = r / (D / 32), nb = r % (D / 32);
                transpose_item(P.w_out, D, D, (_Float16*)(P.ws + W_WTOUT), 32 * nb, 32 * nb, 32, kb, scr, lane); }
        }
    }
    }
    xcd_barrier(bar);
    {
    { const int tid = OTID(), lane = tid & 63, wave = __builtin_amdgcn_readfirstlane(tid >> 6), gw = blockIdx.x * NWAVES + wave, NGW = G * NWAVES;
      for (int tok = gw; tok < TOK; tok += NGW) h_row(P, tok, lane); }
    RUN(256L, it_cconst_fin);
    }
    xcd_barrier(bar);
    const bool cmp_first = (((int)blockIdx.x >> 3) & 1) == 0;
    if (cmp_first) for (int u = blockIdx.x; u < DEC_BATCH * 4; u += G) cmpb::compress_unit(P, (char*)lds_raw, BATCH + (u >> 2), u & 3);
    {
        pg8::Gemm g{(const pg8::bf16_t*)(P.ws + W_H16), (const pg8::bf16_t*)(P.ws + W_WTIN), TOK, LDP, D};
        pg8::StaticOrder S; S.init(TOK, LDP, G, (int)blockIdx.x);
        pg8::EpiProj E{P.ws, P.out};
        pg8::gemm_phase<pg8::EpiProj, pg8::StaticOrder, true, true>(lds, g, S, E);
    }
    {
        const int nun_ = (TOK / 256) * (LDP / 256), full_ = nun_ / G, rem_ = nun_ % G;
        int cw_ = 0, CW_ = G; if (rem_ > 0 && G - rem_ >= 32) { CW_ = G - rem_; cw_ = (int)blockIdx.x - rem_; }
        (void)full_;
        if (cw_ >= 0)
    {
        typedef float f4 __attribute__((ext_vector_type(4)));
        const int t_ = OTID(); const long g0 = (long)cw_ * NTHREADS + t_, gsz = (long)CW_ * NTHREADS;
        constexpr long PERW = (long)(KEEP_S - DEC_SEQ) * 128, NW_ = (long)DEC_BATCH * PERW, PERC = (long)(30 - DEC_SEQ) * 256, NC_ = (long)DEC_BATCH * PERC;
        for (long i0 = g0; i0 < NW_; i0 += 8 * gsz) { f4 v[8];
#pragma unroll
            for (int q = 0; q < 8; ++q) { const long i = i0 + q * gsz; if (i < NW_) { const long b = i / PERW, r = i % PERW; v[q] = ((const f4*)(P.swin + (b * PW + (PW + DEC_SEQ - KEEP_S)) * 512))[r]; } }
#pragma unroll
            for (int q = 0; q < 8; ++q) { const long i = i0 + q * gsz; if (i < NW_) { const long b = i / PERW, r = i % PERW; ((f4*)(P.out + O_WS + b * KEEP_S * 512))[r] = v[q]; } } }
        for (long i0 = g0; i0 < NC_; i0 += 8 * gsz) { f4 v[8];
#pragma unroll
            for (int q = 0; q < 8; ++q) { const long i = i0 + q * gsz; if (i < NC_) { const long b = i / PERC, r = i % PERC; v[q] = ((const f4*)(P.sconv + (b * 30 + DEC_SEQ) * 1024))[r]; } }
#pragma unroll
            for (int q = 0; q < 8; ++q) { const long i = i0 + q * gsz; if (i < NC_) { const long b = i / PERC, r = i % PERC; ((f4*)(P.out + O_CS + b * 30 * 1024))[r] = v[q]; } } }
    }
    }
    if (!cmp_first) for (int u = blockIdx.x; u < DEC_BATCH * 4; u += G) cmpb::compress_unit(P, (char*)lds_raw, BATCH + (u >> 2), u & 3);
    xcd_barrier(bar);
    RUN((long)BATCH * 30 * 1024, it_out_conv_p); RUN((long)DEC_BATCH * DEC_SEQ * 1024, it_out_conv_s_new);
    {
    {
        unsigned* qctr = (unsigned*)P.ws + CW_QATT + 64;
        constexpr int N_CMP = BATCH * 4, N_SAM = DEC_BATCH * 2, N_FW = BATCH * 8 * (SEQ / 256), N_MIX = N_SAM + N_FW, N_CVP = BATCH * (SEQ / 16), N_CVS = DEC_BATCH, N_ALL = N_CMP + N_MIX + N_CVP + N_CVS;
        static_assert(N_SAM == N_FW, "sample units and window blocks alternate one to one");
        for (int first_ = 1;; first_ = 0) {
            if (OTID() == 0) misc[16] = first_ ? blockIdx.x : (unsigned)G + atomicAdd(qctr, 1u);
            __syncthreads(); const int id = __builtin_amdgcn_readfirstlane((int)misc[16]); __syncthreads();
            if (id >= N_ALL) break;
            if (id < N_CMP) cmpb::compress_unit(P, (char*)lds_raw, id >> 2, id & 3);
            else if (id < N_CMP + N_MIX) { const int m = id - N_CMP, u = m >> 1;
                if ((m & 1) == 0) sam::sample_unit(P, (char*)lds_raw, u >> 1, u & 1);
                else {
                    const int qb = (SEQ / 256 - 1) - (u >> 5), bh = u & 31, bb = bh >> 3, h = bh & 7, gg = h >> 2; const long tok0 = (long)bb * SEQ + 256 * qb;
                    const _Float16* kvw = (const _Float16*)(P.ws + W_KVW16) + (long)bb * SEQ * 1536;
                    fa::BlockRef r; r.Q = (const _Float16*)(P.ws + W_Q16) + tok0 * 1024 + h * 128; r.K = kvw + 1024 + gg * 128; r.V = kvw + 1280 + gg * 128;
                    r.O = P.ws + W_OWIN + tok0 * 1024 + h * 128; r.sel = nullptr; r.P0 = 256 * qb; r.W = WINDOW + 1;
                    fa::Seam S; fa::swa_prime(r, (char*)lds_raw, S); fa::swa_block(r, r, SEQ, (char*)lds_raw, S); } }
            else if (id < N_CMP + N_MIX + N_CVP) { const int u = id - N_CMP - N_MIX; { const int t0_ = 16 * (u % (SEQ / 16)); if (t0_ < 30) cvb::conv_unit<16, true>(P, (char*)lds_raw, u / (SEQ / 16), t0_); else cvb::conv_unit<16, false>(P, (char*)lds_raw, u / (SEQ / 16), t0_); } }
            else { const int u = id - N_CMP - N_MIX - N_CVP; cvb::conv_unit<DEC_SEQ, true>(P, (char*)lds_raw, BATCH + u, 0); }
        }
    }
    }
    xcd_barrier(bar);
    for (int u = blockIdx.x; u < BATCH * 2 * (SEQ / 64); u += G) cmpa::unit(P, (char*)lds_raw, u / (2 * (SEQ / 64)), (u / (SEQ / 64)) & 1, u % (SEQ / 64));
    xcd_barrier(bar);
    {
        static_assert(SEQ == 2048 && BATCH == 4, "attention item table is written for 4 x 2048 prompt tokens");
        const int tid = OTID();
        char* flds = (char*)lds_raw;
        unsigned* qctr = (unsigned*)P.ws + CW_QATT;
        constexpr int NITEMS = 256;
#define QFETCH(dst) do { if (tid == 0) misc[16] = qfirst ? blockIdx.x : (unsigned)G + atomicAdd(qctr, 1u); qfirst = 0; __syncthreads(); dst = __builtin_amdgcn_readfirstlane((int)misc[16]); __syncthreads(); } while (0)
#define QDECODE(r, id_) do { const int seg = (id_) >> 5, bh = (id_) & 31, b = bh >> 3, h = bh & 7, g = h >> 2;                                   \
            const int qb = (SEQ / 256 - 1) - seg;                                                                                            \
            const long tok0 = (long)b * SEQ + 256 * qb;                                                                                      \
            const _Float16* kvw = (const _Float16*)(P.ws + W_KVW16) + (long)b * SEQ * 1536;                                                  \
            r.Q = (const _Float16*)(P.ws + W_Q16) + tok0 * 1024 + h * 128;                                                                   \
            r.K = kvw + 512 + g * 128; r.V = kvw + 768 + g * 128;                                                                            \
            r.O = P.ws + W_OSLC + tok0 * 1024 + h * 128;                                                                                     \
            r.sel = (const unsigned*)(P.ws + W_SEL) + (tok0 * 2 + g) * 2;                                                                    \
            r.P0 = 256 * qb; r.W = (1 << 30); } while (0)
        int qfirst = 1;
        constexpr int NGU = (TOK_S / 256) * (D / 256);
        int id; QFETCH(id);
        while (id < NGU) {
            pg8::Gemm g{(const pg8::bf16_t*)(P.ws + W_MIX16), (const pg8::bf16_t*)(P.ws + W_WTOUT), TOK, D, D};
            pg8::OneUnit S1{TOK_P / 256 + id / (D / 256), id % (D / 256)};
            pg8::EpiF32 E{P.ws + W_O2, D};
            pg8::gemm_phase<pg8::EpiF32, pg8::OneUnit, false, true>(lds, g, S1, E);
            QFETCH(id);
        }
        id -= NGU;
        if (id < NITEMS) {
            fa::BlockRef cur, nxt; QDECODE(cur, id); fa::Seam S;
            fa::swa_prime(cur, flds, S);
            for (;;) {
                int nid; QFETCH(nid); nid -= NGU; const bool last = nid >= NITEMS;
                if (last) nxt = cur; else QDECODE(nxt, nid);
                fa::swa_block(cur, nxt, SEQ, flds, S);
                if (last) break;
                cur = nxt;
            }
        }
#undef QFETCH
#undef QDECODE
    }
    xcd_barrier(bar);
    { const int t_ = OTID(), lane_ = t_ & 63, gw_ = blockIdx.x * NWAVES + __builtin_amdgcn_readfirstlane(t_ >> 6); for (int tok_ = gw_; tok_ < TOK_P; tok_ += G * NWAVES) combine_row(P, tok_, lane_); }
    xcd_barrier(bar);
    {
        pg8::Gemm g{(const pg8::bf16_t*)(P.ws + W_MIX16), (const pg8::bf16_t*)(P.ws + W_WTOUT), TOK_P, D, D};
        pg8::StaticOrder S; S.init(TOK_P, D, G, (int)blockIdx.x);
        pg8::EpiF32 E{P.ws + W_O2, D};
        pg8::gemm_phase<pg8::EpiF32, pg8::StaticOrder, true, true>(lds, g, S, E);
    }
    xcd_barrier(bar);
    WAVE_ROWS(y_row);
#undef RUN
#undef RUN_OFF
}

extern "C" void kernel_launch(void* const* d_in, const int* in_sizes, int n_in, void* d_out, int out_size, void* d_ws, size_t ws_size, hipStream_t stream) {
    static int grid = 0;
    if (grid == 0) {
        int dev = 0, cus = 0;
        if (hipGetDevice(&dev) != hipSuccess || hipDeviceGetAttribute(&cus, hipDeviceAttributeMultiprocessorCount, dev) != hipSuccess) { grid = -1; return; }
        if (hipFuncSetAttribute((const void*)fwd_kernel, hipFuncAttributeMaxDynamicSharedMemorySize, LDS_BYTES) != hipSuccess) { grid = -1; return; }
        if ((size_t)W_END * 4 > ws_size || out_size != (int)O_END) { fprintf(stderr, "kernel_launch: ws/out size mismatch (%zu needed, %zu given; out %d vs %ld)\n", (size_t)W_END * 4, ws_size, out_size, (long)O_END); grid = -1; return; }
        (void)hipGetLastError();
        grid = cus;
    }
    if (grid < 0) return;
    (void)hipMemsetAsync(d_ws, 0, 65536, stream);
    Params p{};
    p.x_p = (const float*)d_in[0]; p.x_s = (const float*)d_in[1]; p.c_p = (const float*)d_in[2]; p.c_s = (const float*)d_in[3]; p.cache = (const float*)d_in[4];
    p.ptab = (const int*)d_in[5]; p.swin = (const float*)d_in[6]; p.sconv = (const float*)d_in[7]; p.w_ada = (const float*)d_in[8]; p.b_ada = (const float*)d_in[9];
    p.npre = (const float*)d_in[10]; p.npost = (const float*)d_in[11]; p.w_in = (const float*)d_in[12]; p.pe = (const float*)d_in[13]; p.w1 = (const float*)d_in[14];
    p.b1 = (const float*)d_in[15]; p.w2 = (const float*)d_in[16]; p.b2 = (const float*)d_in[17]; p.dw = (const float*)d_in[18]; p.db = (const float*)d_in[19];
    p.lng = (const float*)d_in[20]; p.lnb = (const float*)d_in[21]; p.w_out = (const float*)d_in[22];
    p.out = (float*)d_out; p.ws = (float*)d_ws;
    hipLaunchKernelGGL(fwd_kernel, dim3(grid), dim3(NTHREADS), LDS_BYTES, stream, p);
}
#endif
```
